# Optimizing an MI355X kernel written in HIP

```python
import jax, jax.numpy as jnp
from jax import lax
import numpy as np

D_MODEL = 1024
BATCH = 4
SEQ = 8192
DEPTH = 2

CHUNK = 64
D_CONV = D_MODEL // 4
CONV_WIDTH = 31
SB_HEAD_DIM = 64
D_SB = D_MODEL // 2
N_SB_HEADS = D_SB // SB_HEAD_DIM
RET_HEAD_DIM = 64
D_RET = D_MODEL // 4
N_RET_HEADS = D_RET // RET_HEAD_DIM
D_MIX = D_CONV + D_SB + D_RET
D_IN_PROJ = 2 * D_CONV + 3 * D_SB + 4 * D_RET
D_FF = ((8 * D_MODEL // 3 + 127) // 128) * 128
Q_BLOCK = 128
ROPE_BASE = 10000.0
EPS = 1e-6

kernel_name = "hybrid_conv_stickbreak_retention_macaron"


def rms_norm(x, g):
    xf = x.astype(jnp.float32)
    y = xf * lax.rsqrt(jnp.mean(xf * xf, axis=-1, keepdims=True) + EPS)
    return (y * g.astype(jnp.float32)).astype(x.dtype)


def layer_norm(x, g, b):
    xf = x.astype(jnp.float32)
    mu = jnp.mean(xf, axis=-1, keepdims=True)
    xc = xf - mu
    var = jnp.mean(xc * xc, axis=-1, keepdims=True)
    return (xc * lax.rsqrt(var + EPS) * g.astype(jnp.float32) + b.astype(jnp.float32)).astype(x.dtype)


def swiglu(h, w_in, w_out):
    gate, up = jnp.split(h @ w_in, 2, axis=-1)
    return (jax.nn.silu(gate) * up) @ w_out


def conv_module(u, conv_w, conv_b, ln_g, ln_b):
    a, b = jnp.split(u, 2, axis=-1)
    v = a * jax.nn.sigmoid(b)
    v = jnp.pad(v, ((0, 0), (CONV_WIDTH - 1, 0), (0, 0)))
    y = lax.conv_general_dilated(
        v, conv_w[:, None, :].astype(v.dtype), window_strides=(1,), padding="VALID",
        dimension_numbers=("NWC", "WIO", "NWC"), feature_group_count=D_CONV)
    y = y + conv_b
    return jax.nn.silu(layer_norm(y, ln_g, ln_b))


def stick_breaking(q, k, v):
    B, S, H, Dh = q.shape
    nb = S // Q_BLOCK
    qb = q.reshape(B, nb, Q_BLOCK, H, Dh).transpose(1, 0, 2, 3, 4)
    kpos = jnp.arange(S)
    scale = Dh ** -0.5

    def block(args):
        qi, i = args
        z = jnp.einsum("bqhd,bkhd->bhqk", qi, k,
                       preferred_element_type=jnp.float32) * scale
        qpos = i * Q_BLOCK + jnp.arange(Q_BLOCK)
        mask = kpos[None, :] < qpos[:, None]
        log_beta = jax.nn.log_sigmoid(z)
        log_not = jnp.where(mask, jax.nn.log_sigmoid(-z), 0.0)
        remain = lax.cumsum(log_not, axis=3, reverse=True) - log_not
        w = jnp.where(mask, jnp.exp(log_beta + remain), 0.0)
        return jnp.einsum("bhqk,bkhd->bqhd", w.astype(v.dtype), v)

    out = lax.map(block, (qb, jnp.arange(nb)))
    return out.transpose(1, 0, 2, 3, 4).reshape(B, S, H, Dh)


def rotary(x, pos):
    half = x.shape[-1] // 2
    inv = 1.0 / (ROPE_BASE ** (jnp.arange(half, dtype=jnp.float32) / half))
    ang = pos.astype(jnp.float32)[:, None] * inv[None, :]
    cos = jnp.cos(ang)[None, :, None, :]
    sin = jnp.sin(ang)[None, :, None, :]
    x1 = x[..., :half].astype(jnp.float32)
    x2 = x[..., half:].astype(jnp.float32)
    return jnp.concatenate([x1 * cos - x2 * sin, x1 * sin + x2 * cos], axis=-1).astype(x.dtype)


def retention(q, k, v):
    B, S, H, Dh = q.shape
    nc = S // CHUNK
    log_gamma = jnp.log1p(-jnp.exp2(-5.0 - jnp.arange(H, dtype=jnp.float32)))
    qc = (q * (Dh ** -0.5)).reshape(B, nc, CHUNK, H, Dh)
    kc = k.reshape(B, nc, CHUNK, H, Dh)
    vc = v.reshape(B, nc, CHUNK, H, Dh)
    idx = jnp.arange(CHUNK, dtype=jnp.float32)
    d_intra = jnp.exp(log_gamma[:, None, None] * jnp.abs(idx[:, None] - idx[None, :]))
    scores = jnp.einsum("bnihd,bnjhd->bnhij", qc, kc,
                        preferred_element_type=jnp.float32) * d_intra
    y_intra = jnp.einsum("bnhij,bnjhe->bnihe", scores, vc.astype(jnp.float32))
    k_decay = jnp.exp(log_gamma[None, :] * (CHUNK - 1 - idx)[:, None])
    kv = jnp.einsum("bnjhd,jh,bnjhe->bnhde", kc.astype(jnp.float32), k_decay,
                    vc.astype(jnp.float32))
    chunk_decay = jnp.exp(log_gamma * CHUNK)[None, :, None, None]

    def step(state, kv_n):
        return chunk_decay * state + kv_n, state

    _, s_prev = lax.scan(step, jnp.zeros((B, H, Dh, Dh), jnp.float32),
                         kv.transpose(1, 0, 2, 3, 4))
    s_prev = s_prev.transpose(1, 0, 2, 3, 4)
    q_decay = jnp.exp(log_gamma[None, :] * (idx + 1.0)[:, None])
    y_cross = jnp.einsum("bnihd,ih,bnhde->bnihe", qc.astype(jnp.float32), q_decay, s_prev)
    return (y_intra + y_cross).reshape(B, S, H, Dh)


def head_norm(y, g):
    B, S, H, Dh = y.shape
    mu = jnp.mean(y, axis=-1, keepdims=True)
    yc = y - mu
    var = jnp.mean(yc * yc, axis=-1, keepdims=True)
    return (yc * lax.rsqrt(var + EPS)).reshape(B, S, H * Dh) * g.astype(jnp.float32)


def hybrid_mixer(h, w_in, conv_w, conv_b, conv_ln_g, conv_ln_b, ret_norm_g, w_out, pos):
    B, S, _ = h.shape
    o1 = 2 * D_CONV
    o2 = o1 + D_SB
    o3 = o2 + D_SB
    o4 = o3 + D_SB
    o5 = o4 + D_RET
    o6 = o5 + D_RET
    o7 = o6 + D_RET
    u_conv, q_sb, k_sb, v_sb, q_r, k_r, v_r, g_r = jnp.split(
        h @ w_in, [o1, o2, o3, o4, o5, o6, o7], axis=-1)
    y_conv = conv_module(u_conv, conv_w, conv_b, conv_ln_g, conv_ln_b)
    sb = lambda t: t.reshape(B, S, N_SB_HEADS, SB_HEAD_DIM)
    y_sb = stick_breaking(sb(q_sb), sb(k_sb), sb(v_sb)).reshape(B, S, D_SB)
    rt = lambda t: t.reshape(B, S, N_RET_HEADS, RET_HEAD_DIM)
    y_r = retention(rotary(rt(q_r), pos), rotary(rt(k_r), pos), rt(v_r))
    y_r = jax.nn.silu(g_r.astype(jnp.float32)) * head_norm(y_r, ret_norm_g)
    y = jnp.concatenate([y_conv, y_sb, y_r.astype(h.dtype)], axis=-1)
    return y @ w_out


def setup_inputs(seed: int = 0) -> dict:
    key = jax.random.key(seed)
    ks = jax.random.split(key, 20)
    f32 = jnp.float32
    nrm = lambda k, shape, scale: jax.random.normal(k, shape, f32) * scale
    gain = lambda k, shape: 1.0 + 0.02 * jax.random.normal(k, shape, f32)
    return {
        "x": jax.random.normal(ks[0], (BATCH, SEQ, D_MODEL), f32),
        "ffn1_norm": gain(ks[1], (DEPTH, D_MODEL)),
        "ffn1_w_in": nrm(ks[2], (DEPTH, D_MODEL, 2 * D_FF), D_MODEL ** -0.5),
        "ffn1_w_out": nrm(ks[3], (DEPTH, D_FF, D_MODEL), D_FF ** -0.5),
        "mix_norm": gain(ks[4], (DEPTH, D_MODEL)),
        "mix_w_in": nrm(ks[5], (DEPTH, D_MODEL, D_IN_PROJ), D_MODEL ** -0.5),
        "conv_w": nrm(ks[6], (DEPTH, CONV_WIDTH, D_CONV), CONV_WIDTH ** -0.5),
        "conv_b": nrm(ks[7], (DEPTH, D_CONV), 0.02),
        "conv_ln_g": gain(ks[8], (DEPTH, D_CONV)),
        "conv_ln_b": nrm(ks[9], (DEPTH, D_CONV), 0.02),
        "ret_norm_g": gain(ks[10], (DEPTH, D_RET)),
        "mix_w_out": nrm(ks[11], (DEPTH, D_MIX, D_MODEL), D_MIX ** -0.5),
        "ffn2_norm": gain(ks[12], (DEPTH, D_MODEL)),
        "ffn2_w_in": nrm(ks[13], (DEPTH, D_MODEL, 2 * D_FF), D_MODEL ** -0.5),
        "ffn2_w_out": nrm(ks[14], (DEPTH, D_FF, D_MODEL), D_FF ** -0.5),
        "final_norm": gain(ks[15], (D_MODEL,)),
    }


def reference(x, ffn1_norm, ffn1_w_in, ffn1_w_out, mix_norm, mix_w_in, conv_w, conv_b,
              conv_ln_g, conv_ln_b, ret_norm_g, mix_w_out, ffn2_norm, ffn2_w_in, ffn2_w_out,
              final_norm):
    S = x.shape[1]
    pos = jnp.arange(S)
    for l in range(DEPTH):
        x = x + 0.5 * swiglu(rms_norm(x, ffn1_norm[l]), ffn1_w_in[l], ffn1_w_out[l])
        x = x + hybrid_mixer(rms_norm(x, mix_norm[l]), mix_w_in[l], conv_w[l], conv_b[l],
                             conv_ln_g[l], conv_ln_b[l], ret_norm_g[l], mix_w_out[l], pos)
        x = x + 0.5 * swiglu(rms_norm(x, ffn2_norm[l]), ffn2_w_in[l], ffn2_w_out[l])
    return rms_norm(x, final_norm)
```

```cpp
#ifndef MK_SPLIT
#define MK_SPLIT 0
#endif
#include <hip/hip_runtime.h>
#include <hip/hip_cooperative_groups.h>
#include <cstdio>
#include <cstdint>
namespace cg = cooperative_groups;
namespace pg8 {
#define PG8_LAS __attribute__((address_space(3)))
typedef unsigned short bf16_t;
typedef short bf16x8 __attribute__((ext_vector_type(8)));
typedef float f32x4 __attribute__((ext_vector_type(4)));
typedef unsigned u32x4 __attribute__((ext_vector_type(4)));
constexpr int BM = 256, BK = 64, HALF = 128, HTB = HALF * BK * 2  , STAGE_BYTES = 8 * HTB, NXCD = 8, WGM = 8;

__host__ __device__ __forceinline__ int lds_byte(int r, int c) { const int st = (r >> 4) * 2 + (c >> 5), rr = r & 15, cc = c & 31, ob = rr * 64 + cc * 2; return st * 1024 + (ob ^ (((ob >> 9) & 1) << 5)); }
__host__ __device__ __forceinline__ void stage_rc(int b, int& R, int& C) { const int st = b / 1024, sb = b % 1024, swz = sb ^ (((sb >> 9) & 1) << 5); R = (st >> 1) * 16 + swz / 64; C = (st & 1) * 32 + (swz % 64) / 2; }
__host__ __device__ __forceinline__ int perm32(int rho) { const int n = rho >> 4, i = rho & 15; return 8 * (i >> 2) + 4 * n + (i & 3); }

struct Unit { int pm, pn; };
struct Gemm { const bf16_t* A; const bf16_t* Bt; int M, N, K; };

struct StaticOrder {
    int nM, nN, nwg, G, c;
    __host__ __device__ void init(int M, int N, int G_, int c_) { nM = M / BM; nN = N / BM; nwg = nM * nN; G = G_; c = c_; }
    __host__ __device__ bool next(int i, Unit& u) const {
        const long L = (long)i * G + c; if (L >= nwg) return false;
        int wgid = (int)L; { const int q = nwg / NXCD, r = nwg % NXCD, xcd = wgid % NXCD, off = wgid / NXCD; wgid = (xcd < r ? xcd * (q + 1) : r * (q + 1) + (xcd - r) * q) + off; }
        const int nig = WGM * nN, gid = wgid / nig, fm = gid * WGM, gsz = (nM - fm) < WGM ? (nM - fm) : WGM;
        u.pm = fm + ((wgid % nig) % gsz); u.pn = (wgid % nig) / gsz; return true;
    }
    __device__ __forceinline__ void a_ready(const Unit&, int) const {}
    __device__ __forceinline__ void done(const Unit&) const {}
};


typedef __bf16 bfx2_t __attribute__((ext_vector_type(2)));
__device__ __forceinline__ unsigned pk2(float lo, float hi) { bfx2_t v; v.x = (__bf16)lo; v.y = (__bf16)hi; return __builtin_bit_cast(unsigned, v); }
__device__ __forceinline__ u32x4 pk8(const f32x4 a, const f32x4 b) { u32x4 w; w.x = pk2(a[0], a[1]); w.y = pk2(a[2], a[3]); w.z = pk2(b[0], b[1]); w.w = pk2(b[2], b[3]); return w; }
__device__ __forceinline__ float rowscale(const float* SS, int row) {
    const f32x4* p = (const f32x4*)(SS + (size_t)row * 16);
    const f32x4 a = p[0], b = p[1], c = p[2], d = p[3];
    const float s = ((a[0] + a[1]) + (a[2] + a[3])) + ((b[0] + b[1]) + (b[2] + b[3])) + ((c[0] + c[1]) + (c[2] + c[3])) + ((d[0] + d[1]) + (d[2] + d[3]));
    return 1.0f / sqrtf(s * (1.0f / 1024.0f) + 1e-6f);
}
__device__ __forceinline__ float sigmoid_f(float x) { return __builtin_amdgcn_rcpf(1.0f + __builtin_amdgcn_exp2f(-1.4426950408889634f * x)); }
__device__ __forceinline__ f32x4 silu4(const f32x4 g) { f32x4 o; o[0] = g[0] * sigmoid_f(g[0]); o[1] = g[1] * sigmoid_f(g[1]); o[2] = g[2] * sigmoid_f(g[2]); o[3] = g[3] * sigmoid_f(g[3]); return o; }
__device__ __forceinline__ f32x4 sig4(const f32x4 g) { f32x4 o; o[0] = sigmoid_f(g[0]); o[1] = sigmoid_f(g[1]); o[2] = sigmoid_f(g[2]); o[3] = sigmoid_f(g[3]); return o; }

struct EpiSwiGLU {
    static constexpr bool PERM = true, AFTER_DRAIN = false;
    bf16_t* H; const PG8_LAS float* rs; int ldh;
    __device__ __forceinline__ void operator()(const f32x4 (&acc)[2][2][4][2], const Unit& u, int wr, int wc, int fr, int fq, int ui) const {
        const int row0 = u.pm * BM + wr * 64 + fr, col0 = u.pn * HALF + wc * 32 + 8 * fq;
#pragma unroll
        for (int ai = 0; ai < 2; ++ai)
#pragma unroll
            for (int m = 0; m < 4; ++m) {
                const int row = row0 + ai * HALF + m * 16; const float r = rs[ui * 256 + ai * HALF + wr * 64 + m * 16 + fr];
                const f32x4 g0 = acc[ai][0][m][0] * r, g1 = acc[ai][0][m][1] * r, u0 = acc[ai][1][m][0] * r, u1 = acc[ai][1][m][1] * r;
                *(u32x4*)(H + (size_t)row * ldh + col0) = pk8(silu4(g0) * u0, silu4(g1) * u1);
            }
    }
};

struct EpiResid {
    static constexpr bool PERM = true, AFTER_DRAIN = false;
    bf16_t* xb; float* SSout; float scale;
    __device__ __forceinline__ void operator()(const f32x4 (&acc)[2][2][4][2], const Unit& u, int wr, int wc, int fr, int fq, int ui) const {
        const int row0 = u.pm * BM + wr * 64 + fr, col0 = u.pn * BM + wc * 32 + 8 * fq;
        u32x4 old[2][4][2];
#pragma unroll
        for (int ai = 0; ai < 2; ++ai)
#pragma unroll
            for (int m = 0; m < 4; ++m)
#pragma unroll
                for (int bj = 0; bj < 2; ++bj) old[ai][m][bj] = *(const u32x4*)(xb + (size_t)(row0 + ai * HALF + m * 16) * 1024 + col0 + bj * HALF);
#pragma unroll
        for (int ai = 0; ai < 2; ++ai)
#pragma unroll
            for (int m = 0; m < 4; ++m) {
                const int row = row0 + ai * HALF + m * 16; float ss = 0.f;
#pragma unroll
                for (int bj = 0; bj < 2; ++bj) {
                    const u32x4 w = old[ai][m][bj];
                    const f32x4 b0 = {__uint_as_float(w.x << 16), __uint_as_float(w.x & 0xffff0000u), __uint_as_float(w.y << 16), __uint_as_float(w.y & 0xffff0000u)};
                    const f32x4 b1 = {__uint_as_float(w.z << 16), __uint_as_float(w.z & 0xffff0000u), __uint_as_float(w.w << 16), __uint_as_float(w.w & 0xffff0000u)};
                    const f32x4 o0 = b0 + acc[ai][bj][m][0] * scale, o1 = b1 + acc[ai][bj][m][1] * scale;
                    *(u32x4*)(xb + (size_t)row * 1024 + col0 + bj * HALF) = pk8(o0, o1);
                    ss += ((o0[0] * o0[0] + o0[1] * o0[1]) + (o0[2] * o0[2] + o0[3] * o0[3])) + ((o1[0] * o1[0] + o1[1] * o1[1]) + (o1[2] * o1[2] + o1[3] * o1[3]));
                }
                ss += __shfl_xor(ss, 16); ss += __shfl_xor(ss, 32);
                if (fq == 0) SSout[(size_t)row * 16 + u.pn * 4 + wc] = ss;
            }
    }
};

struct EpiMixN {
    static constexpr bool PERM = true, AFTER_DRAIN = false;
    bf16_t* P; const PG8_LAS float* rs; const float* cosT; const float* sinT; int ldp;
    __device__ __forceinline__ void operator()(const f32x4 (&acc)[2][2][4][2], const Unit& u, int wr, int wc, int fr, int fq, int ui) const {
        const int row0 = u.pm * BM + wr * 64 + fr, pn = u.pn;
#pragma unroll
        for (int ai = 0; ai < 2; ++ai)
#pragma unroll
            for (int m = 0; m < 4; ++m) {
                const int row = row0 + ai * HALF + m * 16; const float r = rs[ui * 256 + ai * HALF + wr * 64 + m * 16 + fr];
                const f32x4 a0 = acc[ai][0][m][0] * r, a1 = acc[ai][0][m][1] * r, b0 = acc[ai][1][m][0] * r, b1 = acc[ai][1][m][1] * r;
                bf16_t* prow = P + (size_t)row * ldp;
                if (pn < 2) {
                    *(u32x4*)(prow + pn * HALF + wc * 32 + 8 * fq) = pk8(a0 * sig4(b0), a1 * sig4(b1));
                } else if (pn == 6 || pn == 7) {
                    const int pos = row & 8191; const size_t to = (size_t)pos * 32 + 8 * fq;
                    const f32x4 c0 = *(const f32x4*)(cosT + to), c1 = *(const f32x4*)(cosT + to + 4), s0 = *(const f32x4*)(sinT + to), s1 = *(const f32x4*)(sinT + to + 4);
                    const float sc = (pn == 6) ? 0.125f : 1.0f;
                    const f32x4 x0 = (a0 * c0 - b0 * s0) * sc, x1 = (a1 * c1 - b1 * s1) * sc, y0 = (a0 * s0 + b0 * c0) * sc, y1 = (a1 * s1 + b1 * c1) * sc;
                    bf16_t* q = prow + (pn == 6 ? 1280 : 1536) + wc * 64 + 8 * fq;
                    *(u32x4*)(q) = pk8(x0, x1); *(u32x4*)(q + 32) = pk8(y0, y1);
                } else {
                    bf16_t* q = prow + (pn == 8 ? 1792 : 256 + (pn - 2) * 256) + wc * 32 + 8 * fq;
                    *(u32x4*)(q) = pk8(a0, a1); *(u32x4*)(q + HALF) = pk8(b0, b1);
                }
            }
    }
};

struct EpiMixT {
    static constexpr bool PERM = true, AFTER_DRAIN = false;
    bf16_t* T; const PG8_LAS float* rs; const float* cosTT; const float* sinTT; int ldt;
    __device__ __forceinline__ void operator()(const f32x4 (&acc)[2][2][4][2], const Unit& u, int wr, int wc, int fr, int fq, int ui) const {
        const int pm = u.pm;
#pragma unroll
        for (int bj = 0; bj < 2; ++bj) {
            const int tok0 = u.pn * BM + bj * HALF + wc * 32 + 8 * fq;
            const PG8_LAS f32x4* rp = (const PG8_LAS f32x4*)(rs + ui * 256 + bj * HALF + wc * 32 + 8 * fq);
            const f32x4 r0 = rp[0], r1 = rp[1];
            if (pm < 3) {
#pragma unroll
                for (int ai = 0; ai < 2; ++ai)
#pragma unroll
                    for (int m = 0; m < 4; ++m) {
                        const int f = pm * BM + ai * HALF + wr * 64 + m * 16 + fr;
                        *(u32x4*)(T + (size_t)f * ldt + tok0) = pk8(acc[ai][bj][m][0] * r0, acc[ai][bj][m][1] * r1);
                    }
            } else {
                const int pos0 = tok0 & 8191, tk = tok0 & 63;
#pragma unroll
                for (int m = 0; m < 4; ++m) {
                    const int x = wr * 64 + m * 16 + fr, hh = x >> 5, dd = x & 31;
                    const float lg = (hh == 0) ? -0.04580368961312479f : (hh == 1) ? -0.02272007650008353f : (hh == 2) ? -0.011315313227834146f : -0.005646563141142063f;
                    f32x4 k0, k1;
#pragma unroll
                    for (int e = 0; e < 4; ++e) { k0[e] = __builtin_amdgcn_exp2f(lg * (float)(63 - tk - e)); k1[e] = __builtin_amdgcn_exp2f(lg * (float)(59 - tk - e)); }
                    const size_t to = (size_t)dd * 8192 + pos0;
                    const f32x4 c0 = *(const f32x4*)(cosTT + to), c1 = *(const f32x4*)(cosTT + to + 4), s0 = *(const f32x4*)(sinTT + to), s1 = *(const f32x4*)(sinTT + to + 4);
                    const f32x4 a0 = acc[0][bj][m][0] * r0, a1 = acc[0][bj][m][1] * r1, b0 = acc[1][bj][m][0] * r0, b1 = acc[1][bj][m][1] * r1;
                    const f32x4 x0 = (a0 * c0 - b0 * s0) * k0, x1 = (a1 * c1 - b1 * s1) * k1, y0 = (a0 * s0 + b0 * c0) * k0, y1 = (a1 * s1 + b1 * c1) * k1;
                    bf16_t* q = T + (size_t)(768 + hh * 64 + dd) * ldt + tok0;
                    *(u32x4*)(q) = pk8(x0, x1); *(u32x4*)(q + (size_t)32 * ldt) = pk8(y0, y1);
                }
            }
        }
    }
};

template <class Epi, class Sched, bool ALIGN_EPI = false, bool SP2 = false>
__device__ __forceinline__ void gemm_phase(PG8_LAS unsigned char* lds, const Gemm g, const Sched& S, const Epi& E) {
    const int tid = threadIdx.x, wid = __builtin_amdgcn_readfirstlane(tid >> 6), lane = tid & 63, wr = wid >> 2, wc = wid & 3, fr = lane & 15, fq = lane >> 4;
    const int K = g.K, nt = K / BK;
    unsigned voffA[2], voffB[2];
#pragma unroll
    for (int i = 0; i < 2; ++i) { int R, C; stage_rc(tid * 16 + i * 8192, R, C); const int Rb = Epi::PERM ? ((R & ~31) + perm32(R & 31)) : R;
        voffA[i] = (unsigned)(R * K + C) * 2u; voffB[i] = (unsigned)(Rb * K + C) * 2u; }
    const size_t kstep = (size_t)(BK * 2);
    const size_t hstep = (size_t)HALF * K * 2;
    const size_t tstep = 2 * hstep;
    const unsigned ldsw = (unsigned)wid * 1024u;
    const int aoff = lds_byte(wr * 64 + fr, fq * 8), boff = lds_byte(wc * 32 + fr, fq * 8);
#define PG8_SA(b, h) (((b) * 2 + (h)) * HTB)
#define PG8_SB(b, h) ((4 + (b) * 2 + (h)) * HTB)
#define PG8_STAGE(bufoff, gbase, voff) do { _Pragma("unroll") for (int _i = 0; _i < 2; ++_i) \
        __builtin_amdgcn_global_load_lds((const unsigned*)((const char*)(gbase) + (voff)[_i]), (PG8_LAS unsigned*)(lds + (bufoff) + ldsw + _i * 8192), 16, 0, 0); } while (0)
#define PG8_LDA(dst, b, h) do { _Pragma("unroll") for (int m = 0; m < 4; ++m) _Pragma("unroll") for (int k = 0; k < 2; ++k) dst[m][k] = *(const PG8_LAS bf16x8*)(lds + PG8_SA(b, h) + aoff + m * 2048 + k * 1024); } while (0)
#define PG8_LDB(dst, b, h) do { _Pragma("unroll") for (int n = 0; n < 2; ++n) _Pragma("unroll") for (int k = 0; k < 2; ++k) dst[n][k] = *(const PG8_LAS bf16x8*)(lds + PG8_SB(b, h) + boff + n * 2048 + k * 1024); } while (0)
#define PG8_MMA(ai, bj, At, Bt) do { __builtin_amdgcn_s_setprio(1); _Pragma("unroll") for (int m = 0; m < 4; ++m) _Pragma("unroll") for (int n = 0; n < 2; ++n) _Pragma("unroll") for (int k = 0; k < 2; ++k) \
        acc[ai][bj][m][n] = __builtin_amdgcn_mfma_f32_16x16x32_bf16(Bt[n][k], At[m][k], acc[ai][bj][m][n], 0, 0, 0); __builtin_amdgcn_s_setprio(0); } while (0)
#define PG8_WAIT_V(n) asm volatile("s_waitcnt vmcnt(" #n ")" ::: "memory")
#define PG8_WAIT_L(n) asm volatile("s_waitcnt lgkmcnt(" #n ")" ::: "memory")
#define PG8_BAR __builtin_amdgcn_s_barrier()
#define PG8_SCHED __builtin_amdgcn_sched_barrier(0)
    Unit cur, nxt; int ui = 0;
    if (!S.next(0, cur)) return;
    f32x4 acc[2][2][4][2];
#pragma unroll
    for (int a = 0; a < 2; ++a)
#pragma unroll
        for (int b = 0; b < 2; ++b)
#pragma unroll
            for (int m = 0; m < 4; ++m)
#pragma unroll
                for (int n = 0; n < 2; ++n) acc[a][b][m][n] = (f32x4){0.f, 0.f, 0.f, 0.f};
    bf16x8 At[4][2], B0[2][2], B1[2][2];
    const char* cA = (const char*)g.A + (size_t)cur.pm * tstep; const char* cB = (const char*)g.Bt + (size_t)cur.pn * tstep;
    S.a_ready(cur, 0);
    if constexpr (SP2) {
        PG8_STAGE(PG8_SB(0, 0), cB, voffB); PG8_STAGE(PG8_SB(0, 1), cB + hstep, voffB); PG8_STAGE(PG8_SA(0, 0), cA, voffA); PG8_STAGE(PG8_SA(0, 1), cA + hstep, voffA);
        if (wr == 1) PG8_BAR;
        PG8_WAIT_V(2); PG8_BAR;
        PG8_STAGE(PG8_SB(1, 0), cB + kstep, voffB); PG8_STAGE(PG8_SA(1, 0), cA + kstep, voffA); PG8_STAGE(PG8_SB(1, 1), cB + hstep + kstep, voffB);
        PG8_WAIT_V(6); PG8_BAR;
    } else {
        PG8_STAGE(PG8_SB(0, 0), cB, voffB); PG8_STAGE(PG8_SA(0, 0), cA, voffA); PG8_STAGE(PG8_SB(0, 1), cB + hstep, voffB); PG8_STAGE(PG8_SA(0, 1), cA + hstep, voffA);
        if (wr == 1) PG8_BAR;
        PG8_WAIT_V(4); PG8_BAR;
        PG8_STAGE(PG8_SB(1, 0), cB + kstep, voffB); PG8_STAGE(PG8_SA(1, 0), cA + kstep, voffA); PG8_STAGE(PG8_SB(1, 1), cB + hstep + kstep, voffB);
        PG8_WAIT_V(6); PG8_BAR;
    }
    for (;;) {
        const bool has_next = S.next(ui + 1, nxt);
        const char* nA = has_next ? (const char*)g.A + (size_t)nxt.pm * tstep : cA; const char* nB = has_next ? (const char*)g.Bt + (size_t)nxt.pn * tstep : cB;
        for (int t = 0; t < nt; t += 2) {
            const bool last = (t == nt - 2);
            const char* a1 = cA + (size_t)(t + 1) * kstep;
            const char* a2 = last ? nA : cA + (size_t)(t + 2) * kstep; const char* b2 = last ? nB : cB + (size_t)(t + 2) * kstep;
            const char* a3 = a2 + kstep; const char* b3 = b2 + kstep;
            if (last && has_next) S.a_ready(nxt, ui + 1);
            if constexpr (SP2) {
            PG8_LDB(B0, 0, 0); PG8_LDB(B1, 0, 1); PG8_SCHED; PG8_LDA(At, 0, 0); PG8_STAGE(PG8_SA(1, 1), a1 + hstep, voffA);
            PG8_WAIT_V(8); PG8_WAIT_L(0); PG8_BAR; PG8_MMA(0, 0, At, B0); PG8_MMA(0, 1, At, B1); PG8_BAR; PG8_SCHED;
            PG8_LDA(At, 0, 1); PG8_STAGE(PG8_SB(0, 0), b2, voffB); PG8_STAGE(PG8_SB(0, 1), b2 + hstep, voffB); PG8_STAGE(PG8_SA(0, 0), a2, voffA);
            PG8_WAIT_V(8); PG8_WAIT_L(0); PG8_BAR; PG8_MMA(1, 0, At, B0); PG8_MMA(1, 1, At, B1); PG8_BAR; PG8_SCHED;
            PG8_LDB(B0, 1, 0); PG8_LDB(B1, 1, 1); PG8_SCHED; PG8_LDA(At, 1, 0); PG8_STAGE(PG8_SA(0, 1), a2 + hstep, voffA);
            PG8_WAIT_V(8); PG8_WAIT_L(0); PG8_BAR; PG8_MMA(0, 0, At, B0); PG8_MMA(0, 1, At, B1); PG8_BAR; PG8_SCHED;
            PG8_LDA(At, 1, 1); PG8_STAGE(PG8_SB(1, 0), b3, voffB); PG8_STAGE(PG8_SB(1, 1), b3 + hstep, voffB); PG8_STAGE(PG8_SA(1, 0), a3, voffA);
            PG8_WAIT_V(8); PG8_WAIT_L(0); PG8_BAR; PG8_MMA(1, 0, At, B0); PG8_MMA(1, 1, At, B1); PG8_BAR; PG8_SCHED;
            } else {
            PG8_LDB(B0, 0, 0); PG8_SCHED; PG8_LDA(At, 0, 0); PG8_STAGE(PG8_SA(1, 1), a1 + hstep, voffA);
            PG8_WAIT_L(8); PG8_BAR; PG8_WAIT_L(0); PG8_MMA(0, 0, At, B0); PG8_BAR; PG8_SCHED;
            PG8_LDB(B1, 0, 1); PG8_STAGE(PG8_SB(0, 0), b2, voffB);
            PG8_BAR; PG8_WAIT_L(0); PG8_MMA(0, 1, At, B1); PG8_BAR;
            PG8_LDA(At, 0, 1); PG8_STAGE(PG8_SA(0, 0), a2, voffA);
            PG8_BAR; PG8_WAIT_L(0); PG8_MMA(1, 0, At, B0); PG8_BAR; PG8_SCHED;
            PG8_STAGE(PG8_SB(0, 1), b2 + hstep, voffB);
            PG8_WAIT_V(6); PG8_BAR; PG8_MMA(1, 1, At, B1); PG8_BAR;
            PG8_LDB(B0, 1, 0); PG8_SCHED; PG8_LDA(At, 1, 0); PG8_STAGE(PG8_SA(0, 1), a2 + hstep, voffA);
            PG8_WAIT_L(8); PG8_BAR; PG8_WAIT_L(0); PG8_MMA(0, 0, At, B0); PG8_BAR; PG8_SCHED;
            PG8_LDB(B1, 1, 1); PG8_STAGE(PG8_SB(1, 0), b3, voffB);
            PG8_BAR; PG8_WAIT_L(0); PG8_MMA(0, 1, At, B1); PG8_BAR;
            PG8_LDA(At, 1, 1); PG8_STAGE(PG8_SA(1, 0), a3, voffA);
            PG8_BAR; PG8_WAIT_L(0); PG8_MMA(1, 0, At, B0); PG8_BAR; PG8_SCHED;
            PG8_STAGE(PG8_SB(1, 1), b3 + hstep, voffB);
            PG8_WAIT_V(6); PG8_BAR; PG8_MMA(1, 1, At, B1); PG8_BAR;
            }
        }
        if constexpr (ALIGN_EPI) { if (wr == 0) PG8_BAR; }
        if constexpr (!Epi::AFTER_DRAIN) { E(acc, cur, wr, wc, fr, fq, ui); S.done(cur); }
        if (!has_next) break;
#pragma unroll
        for (int a = 0; a < 2; ++a)
#pragma unroll
            for (int b = 0; b < 2; ++b)
#pragma unroll
                for (int m = 0; m < 4; ++m)
#pragma unroll
                    for (int n = 0; n < 2; ++n) acc[a][b][m][n] = (f32x4){0.f, 0.f, 0.f, 0.f};
        cur = nxt; cA = nA; cB = nB; ++ui;
        if constexpr (ALIGN_EPI) { if (wr == 1) PG8_BAR; }
    }
    PG8_WAIT_V(0);
    if constexpr (!ALIGN_EPI) { if (wr == 0) PG8_BAR; }
    PG8_BAR;
    if constexpr (Epi::AFTER_DRAIN) { E.fused(acc, cur, wr, wc, fr, fq, lds, wid, lane); S.done(cur); }
#undef PG8_SA
#undef PG8_SB
#undef PG8_STAGE
#undef PG8_LDA
#undef PG8_LDB
#undef PG8_MMA
#undef PG8_WAIT_V
#undef PG8_WAIT_L
#undef PG8_BAR
#undef PG8_SCHED
}
}

constexpr int BATCH = 4, SEQ = 8192, DM = 1024, DEPTH = 2, M_TOK = BATCH * SEQ;
constexpr int FF = 2816, NFF = 2 * FF, NMIX = 3072;
constexpr int PW = 2048 + 64;
constexpr int LDT = M_TOK + 64;
constexpr int P_CV = 0, P_QSB = 256, P_KSB = 768, P_QR = 1280, P_KR = 1536, P_GR = 1792;
constexpr int T_VSB = 0, T_VR = 512, T_KR = 768;
constexpr int Y_CV = 0, Y_SB = 256, Y_R = 768;
constexpr int GC = 4, NG = (SEQ / 64) / GC;
constexpr int NWAVES = 8, NTHR = NWAVES * 64;
constexpr int SB_PART1 = 0;
constexpr int LDS_BYTES = 147456;

constexpr size_t MiB = 1u << 20;
constexpr size_t WS_CTL = 0, CTL_BYTES = 65536;
constexpr size_t WS_W = 1 * MiB, W_STRIDE = 42 * MiB;
constexpr size_t WO_1I = 0, WO_1O = 11 * MiB, WO_MN = 33 * MiB / 2, WO_MT = 21 * MiB, WO_MO = 23 * MiB, WO_2I = 25 * MiB, WO_2O = 36 * MiB;
constexpr size_t WS_ROT = 85 * MiB;
constexpr size_t WS_SS = 89 * MiB;
constexpr size_t WS_G = 91 * MiB;
constexpr size_t WS_XB = 100 * MiB, WS_Y = 164 * MiB, WS_T = 228 * MiB, WS_H = 293 * MiB, WS_SP = 469 * MiB, WS_END = 477 * MiB;

#define LAS __attribute__((address_space(3)))
#define DI __device__ __forceinline__
typedef unsigned short bf16_t;
typedef __bf16 bfx8 __attribute__((ext_vector_type(8)));
typedef float f32x16 __attribute__((ext_vector_type(16)));
typedef float f32x4 __attribute__((ext_vector_type(4)));
typedef unsigned u32x4 __attribute__((ext_vector_type(4)));
typedef unsigned u32x2 __attribute__((ext_vector_type(2)));
#define MFMA32(a, b, c) __builtin_amdgcn_mfma_f32_32x32x16_bf16((a), (b), (c), 0, 0, 0)
#define EXP2(x) __builtin_amdgcn_exp2f(x)
#define LOG2(x) __builtin_amdgcn_logf(x)
using pg8::pk2;

DI int crow(int reg, int h) { return (reg & 3) + 8 * (reg >> 2) + 4 * h; }
DI f32x16 zero16() { f32x16 z;
#pragma unroll
    for (int i = 0; i < 16; ++i) z[i] = 0.f; return z; }
template <int S> DI bfx8 pack8(const f32x16& x) {
    u32x4 p; p.x = pk2(x[8 * S], x[8 * S + 1]); p.y = pk2(x[8 * S + 2], x[8 * S + 3]); p.z = pk2(x[8 * S + 4], x[8 * S + 5]); p.w = pk2(x[8 * S + 6], x[8 * S + 7]);
    return __builtin_bit_cast(bfx8, p);
}
DI bfx8 ld8(const bf16_t* p) { return *(const bfx8*)p; }
DI bfx8 ld44(const bf16_t* p) { u32x4 v; const u32x2 a = *(const u32x2*)p, b = *(const u32x2*)(p + 8); v.x = a.x; v.y = a.y; v.z = b.x; v.w = b.y; return __builtin_bit_cast(bfx8, v); }
DI bfx8 lds44(const LAS unsigned char* img, int row, int x, int hi) { const int sw = (row >> 1) & 7; u32x4 v; const u32x2 a = *(const LAS u32x2*)(img + row * 128 + (((2 * x) ^ sw) << 4) + 8 * hi), b = *(const LAS u32x2*)(img + row * 128 + (((2 * x + 1) ^ sw) << 4) + 8 * hi); v.x = a.x; v.y = a.y; v.z = b.x; v.w = b.y; return __builtin_bit_cast(bfx8, v); }
DI float bf_lo(unsigned u) { return __uint_as_float(u << 16); }
DI float bf_hi(unsigned u) { return __uint_as_float(u & 0xffff0000u); }
DI float wave_sum(float v) {
#pragma unroll
    for (int o = 1; o < 64; o <<= 1) v += __shfl_xor(v, o);
    return v;
}
DI float lgamma2(int h) { return (h == 0) ? -0.04580368961312479f : (h == 1) ? -0.02272007650008353f : (h == 2) ? -0.011315313227834146f : -0.005646563141142063f; }

#define SB_TILE(QF, O0, O1, RR, TQ) do { \
        f32x16 s0 = zero16(), s1 = zero16(); \
        _Pragma("unroll") for (int kk = 0; kk < 4; ++kk) { \
            const bfx8 k0 = *(const LAS bfx8*)(kl0 + (((2 * kk + hi) ^ ksw) << 4)), k1 = *(const LAS bfx8*)(kl0 + 4096 + (((2 * kk + hi) ^ ksw) << 4)); \
            s0 = MFMA32(k0, QF[kk], s0); s1 = MFMA32(k1, QF[kk], s1); } \
        bfx8 v00, v01, v02, v03, v10, v11, v12, v13;          \
        { v00 = *(const LAS bfx8*)(vl0 + (((2 * hi) ^ vsw) << 4)); v01 = *(const LAS bfx8*)(vl0 + (((2 * hi + 1) ^ vsw) << 4)); v02 = *(const LAS bfx8*)(vl0 + (((4 + 2 * hi) ^ vsw) << 4)); v03 = *(const LAS bfx8*)(vl0 + (((5 + 2 * hi) ^ vsw) << 4)); \
          v10 = *(const LAS bfx8*)(vl0 + 4096 + (((2 * hi) ^ vsw) << 4)); v11 = *(const LAS bfx8*)(vl0 + 4096 + (((2 * hi + 1) ^ vsw) << 4)); v12 = *(const LAS bfx8*)(vl0 + 4096 + (((4 + 2 * hi) ^ vsw) << 4)); v13 = *(const LAS bfx8*)(vl0 + 4096 + (((5 + 2 * hi) ^ vsw) << 4)); } \
          \
        _Pragma("unroll") for (int i = 0; i < 16; ++i) { \
            { float om = __builtin_amdgcn_rcpf(1.0f + EXP2(fminf(s0[i] * ZC, 64.0f))); \
              if (diag) om = ((key0 + i) < (TQ)) ? om : 1.0f; \
              s0[i] = om; } \
            { float om = __builtin_amdgcn_rcpf(1.0f + EXP2(fminf(s1[i] * ZC, 64.0f))); \
              if (diag) om = ((key0 + 32 + i) < (TQ)) ? om : 1.0f; \
              s1[i] = om; } } \
        const float m0 = (((s0[0] * s0[1]) * (s0[2] * s0[3])) * ((s0[4] * s0[5]) * (s0[6] * s0[7]))) * (((s0[8] * s0[9]) * (s0[10] * s0[11])) * ((s0[12] * s0[13]) * (s0[14] * s0[15]))); \
        const float m1 = (((s1[0] * s1[1]) * (s1[2] * s1[3])) * ((s1[4] * s1[5]) * (s1[6] * s1[7]))) * (((s1[8] * s1[9]) * (s1[10] * s1[11])) * ((s1[12] * s1[13]) * (s1[14] * s1[15]))); \
        const float x0 = __shfl_xor(m0, 32), x1 = __shfl_xor(m1, 32);     \
        const float c1 = (hi == 0) ? RR * x1 : RR;            \
        const float base = RR * (m1 * x1); \
        const float c0 = (hi == 0) ? base * x0 : base; \
        RR = base * (m0 * x0); \
        { float t = c1; _Pragma("unroll") for (int i = 15; i >= 0; --i) { const float l = s1[i]; s1[i] = __builtin_fmaf(-l, t, t); t *= l; } } \
        { float t = c0; _Pragma("unroll") for (int i = 15; i >= 0; --i) { const float l = s0[i]; s0[i] = __builtin_fmaf(-l, t, t); t *= l; } } \
        { const bfx8 w = pack8<0>(s0); O0 = MFMA32(v00, w, O0); O1 = MFMA32(v10, w, O1); } \
        { const bfx8 w = pack8<1>(s0); O0 = MFMA32(v01, w, O0); O1 = MFMA32(v11, w, O1); } \
        { const bfx8 w = pack8<0>(s1); O0 = MFMA32(v02, w, O0); O1 = MFMA32(v12, w, O1); } \
        { const bfx8 w = pack8<1>(s1); O0 = MFMA32(v03, w, O0); O1 = MFMA32(v13, w, O1); } } while (0)

DI void sb_unit(int item, const bf16_t* __restrict__ P, const bf16_t* __restrict__ T, bf16_t* __restrict__ Y, int lane, LAS unsigned char* wl) {
    const int qp2 = item & 127, bh = item >> 7, b = bh >> 3, h = bh & 7;
    const int n = lane & 31, hi = lane >> 5;
    const int t0 = qp2 * 64, tqa = t0 + n, tqb = t0 + 32 + n;
    const size_t tokb = (size_t)b * SEQ;
    bfx8 qa[4], qb[4];
    {
        const int srow_ = lane >> 3, sch_ = lane & 7;
        const bf16_t* qg = P + (tokb + t0 + srow_) * PW + P_QSB + h * 64 + 8 * sch_;
        u32x4 qr[8];
#pragma unroll
        for (int i = 0; i < 8; ++i) qr[i] = *(const u32x4*)(qg + (size_t)(8 * i) * PW);
#pragma unroll
        for (int i = 0; i < 8; ++i) { const int r = 8 * i + srow_; *(LAS u32x4*)(wl + r * 128 + ((sch_ ^ ((r >> 1) & 7)) << 4)) = qr[i]; }
#pragma unroll
        for (int kk = 0; kk < 4; ++kk) { qa[kk] = *(const LAS bfx8*)(wl + n * 128 + (((2 * kk + hi) ^ ((n >> 1) & 7)) << 4)); qb[kk] = *(const LAS bfx8*)(wl + (32 + n) * 128 + (((2 * kk + hi) ^ ((n >> 1) & 7)) << 4)); }
    }
    f32x16 oa0 = zero16(), oa1 = zero16(), ob0 = zero16(), ob1 = zero16(); float Ra = 1.0f, Rb = 1.0f;
    const int kmap = 16 * ((n >> 2) & 1) + 4 * (n >> 3) + (n & 3);
    const int srow = lane >> 3, sch = lane & 7;
    const bf16_t* kg = P + (tokb + srow) * PW + P_KSB + h * 64 + 8 * sch;
    const bf16_t* vg = T + (size_t)(T_VSB + h * 64 + srow) * LDT + tokb + 8 * sch;
    const LAS unsigned char* kl0 = wl + kmap * 128; const int ksw = (kmap >> 1) & 7;
    const LAS unsigned char* vl0 = wl + 8192 + n * 128; const int vsw = (n >> 1) & 7;
    const int kd = t0 >> 6;
    const float ZC = 0.18033688011112042f;
    bool livea = true, liveb = true;
    for (int kt = kd; kt >= 0; --kt) {
        const int kbase = kt * 64;
        { u32x4 kr[8], vr[8];
#pragma unroll
          for (int i = 0; i < 8; ++i) { kr[i] = *(const u32x4*)(kg + (size_t)(kbase + 8 * i) * PW); vr[i] = *(const u32x4*)(vg + (size_t)(8 * i) * LDT + kbase); }
#pragma unroll
          for (int i = 0; i < 8; ++i) { const int r = 8 * i + srow; const int off = r * 128 + ((sch ^ ((r >> 1) & 7)) << 4);
              *(LAS u32x4*)(wl + off) = kr[i]; *(LAS u32x4*)(wl + 8192 + off) = vr[i]; } }
        const bool diag = (kt == kd);
        const int key0 = kbase + 16 * hi;
        if (livea) { SB_TILE(qa, oa0, oa1, Ra, tqa); livea = __builtin_amdgcn_ballot_w64(Ra > 1e-36f) != 0ull; }
        if (liveb) { SB_TILE(qb, ob0, ob1, Rb, tqb); liveb = __builtin_amdgcn_ballot_w64(Rb > 1e-36f) != 0ull; }
        if (!livea && !liveb) break;
    }
    {
#pragma unroll
        for (int g = 0; g < 4; ++g) {
            const int ra = n, rb = 32 + n;
            u32x2 w; w.x = pk2(oa0[4 * g], oa0[4 * g + 1]); w.y = pk2(oa0[4 * g + 2], oa0[4 * g + 3]); *(LAS u32x2*)(wl + ra * 128 + (((g) ^ ((ra >> 1) & 7)) << 4) + 8 * hi) = w;
            u32x2 w2; w2.x = pk2(oa1[4 * g], oa1[4 * g + 1]); w2.y = pk2(oa1[4 * g + 2], oa1[4 * g + 3]); *(LAS u32x2*)(wl + ra * 128 + (((4 + g) ^ ((ra >> 1) & 7)) << 4) + 8 * hi) = w2;
            u32x2 w3; w3.x = pk2(ob0[4 * g], ob0[4 * g + 1]); w3.y = pk2(ob0[4 * g + 2], ob0[4 * g + 3]); *(LAS u32x2*)(wl + rb * 128 + (((g) ^ ((rb >> 1) & 7)) << 4) + 8 * hi) = w3;
            u32x2 w4; w4.x = pk2(ob1[4 * g], ob1[4 * g + 1]); w4.y = pk2(ob1[4 * g + 2], ob1[4 * g + 3]); *(LAS u32x2*)(wl + rb * 128 + (((4 + g) ^ ((rb >> 1) & 7)) << 4) + 8 * hi) = w4;
        }
        bf16_t* yg = Y + (tokb + t0 + srow) * DM + Y_SB + h * 64 + 8 * sch;
#pragma unroll
        for (int i = 0; i < 8; ++i) { const int r = 8 * i + srow; *(u32x4*)(yg + (size_t)(8 * i) * DM) = *(const LAS u32x4*)(wl + r * 128 + ((sch ^ ((r >> 1) & 7)) << 4)); }
    }
}

DI void conv_unit(int item, const bf16_t* __restrict__ P, bf16_t* __restrict__ Y, const float* __restrict__ cw, const float* __restrict__ cb,
                  const float* __restrict__ lng, const float* __restrict__ lnb, int lane) {
    const int tok0 = item * 16;
    f32x4 w[31];
#pragma unroll
    for (int j = 0; j < 31; ++j) w[j] = *(const f32x4*)(cw + j * 256 + 4 * lane);
    const f32x4 bias = *(const f32x4*)(cb + 4 * lane), g4 = *(const f32x4*)(lng + 4 * lane), b4 = *(const f32x4*)(lnb + 4 * lane);
#pragma unroll 1
    for (int ps = 0; ps < 4; ++ps) {
        const int tok = tok0 + 4 * ps, tl = tok & (SEQ - 1);
        const bf16_t* src = P + (size_t)tok * PW + P_CV + 4 * lane;
        u32x2 r[34];
#pragma unroll
        for (int i = 0; i < 34; ++i) { const bool ok = (tl - 30 + i) >= 0; const u32x2 v = *(const u32x2*)(src + (ok ? (i - 30) * PW : 0)); r[i].x = ok ? v.x : 0u; r[i].y = ok ? v.y : 0u; }
        f32x4 acc[4];
#pragma unroll
        for (int tt = 0; tt < 4; ++tt) { acc[tt] = bias;
#pragma unroll
            for (int j = 0; j < 31; ++j) { const u32x2 v = r[tt + j]; f32x4 x; x[0] = bf_lo(v.x); x[1] = bf_hi(v.x); x[2] = bf_lo(v.y); x[3] = bf_hi(v.y); acc[tt] += w[j] * x; } }
        float mean[4], var[4];
#pragma unroll
        for (int tt = 0; tt < 4; ++tt) mean[tt] = (acc[tt][0] + acc[tt][1]) + (acc[tt][2] + acc[tt][3]);
#pragma unroll
        for (int o = 1; o < 64; o <<= 1) {
#pragma unroll
            for (int tt = 0; tt < 4; ++tt) mean[tt] += __shfl_xor(mean[tt], o); }
#pragma unroll
        for (int tt = 0; tt < 4; ++tt) { mean[tt] *= (1.0f / 256.0f); acc[tt] -= mean[tt]; var[tt] = (acc[tt][0] * acc[tt][0] + acc[tt][1] * acc[tt][1]) + (acc[tt][2] * acc[tt][2] + acc[tt][3] * acc[tt][3]); }
#pragma unroll
        for (int o = 1; o < 64; o <<= 1) {
#pragma unroll
            for (int tt = 0; tt < 4; ++tt) var[tt] += __shfl_xor(var[tt], o); }
#pragma unroll
        for (int tt = 0; tt < 4; ++tt) {
            const float rs = 1.0f / sqrtf(var[tt] * (1.0f / 256.0f) + 1e-6f);
            const f32x4 y = pg8::silu4(acc[tt] * rs * g4 + b4);
            u32x2 o; o.x = pk2(y[0], y[1]); o.y = pk2(y[2], y[3]);
            *(u32x2*)(Y + (size_t)(tok + tt) * DM + Y_CV + 4 * lane) = o;
        }
    }
}

#define RET_STAGE(img_, gbase_, pitch_) do { \
    u32x4 r_[8]; \
    _Pragma("unroll") for (int i_ = 0; i_ < 8; ++i_) r_[i_] = *(const u32x4*)((gbase_) + (size_t)(8 * i_ + (lane >> 3)) * (pitch_) + 8 * (lane & 7)); \
    _Pragma("unroll") for (int i_ = 0; i_ < 8; ++i_) { const int rr_ = 8 * i_ + (lane >> 3); *(LAS u32x4*)((img_) + rr_ * 128 + (((lane & 7) ^ ((rr_ >> 1) & 7)) << 4)) = r_[i_]; } } while (0)
#define RET_STAGE_LOAD(r_, n_, gbase_, pitch_) do { _Pragma("unroll") for (int i_ = 0; i_ < (n_); ++i_) r_[i_] = *(const u32x4*)((gbase_) + (size_t)(8 * i_ + (lane >> 3)) * (pitch_) + 8 * (lane & 7)); } while (0)
#define RET_STAGE_STORE(img_, r_, n_) do { _Pragma("unroll") for (int i_ = 0; i_ < (n_); ++i_) { const int rr_ = 8 * i_ + (lane >> 3); *(LAS u32x4*)((img_) + rr_ * 128 + (((lane & 7) ^ ((rr_ >> 1) & 7)) << 4)) = r_[i_]; } } while (0)
#define RET_FRAG(img_, row_, chunk_) (*(const LAS bfx8*)((img_) + (row_) * 128 + (((chunk_) ^ (((row_) >> 1) & 7)) << 4)))
#define RET_UPDATE(kimg_, vimg_) do { \
    _Pragma("unroll") for (int js = 0; js < 4; ++js) { \
        const bfx8 a0_ = RET_FRAG(kimg_, n, 2 * js + hi), a1_ = RET_FRAG(kimg_, 32 + n, 2 * js + hi), b0_ = RET_FRAG(vimg_, n, 2 * js + hi), b1_ = RET_FRAG(vimg_, 32 + n, 2 * js + hi); \
        st00 = MFMA32(a0_, b0_, st00); st01 = MFMA32(a0_, b1_, st01); st10 = MFMA32(a1_, b0_, st10); st11 = MFMA32(a1_, b1_, st11); } } while (0)

DI void ret1_unit(int item, const bf16_t* __restrict__ T, float* __restrict__ G, int lane, LAS unsigned char* wl) {
    const int g = item % NG, bh = item / NG, b = bh >> 2, h = bh & 3;
    const int n = lane & 31, hi = lane >> 5;
    const float cd = EXP2(lgamma2(h) * 64.0f);
    f32x16 st00 = zero16(), st01 = zero16(), st10 = zero16(), st11 = zero16();
    for (int c = 0; c < GC; ++c) {
        const size_t tb = (size_t)b * SEQ + (size_t)(g * GC + c) * 64;
        if (c > 0) { st00 *= cd; st01 *= cd; st10 *= cd; st11 *= cd; }
        RET_STAGE(wl, T + (size_t)(T_KR + h * 64) * LDT + tb, LDT); RET_STAGE(wl + 8192, T + (size_t)(T_VR + h * 64) * LDT + tb, LDT);
        RET_UPDATE(wl, wl + 8192);
    }
    f32x4* gp = (f32x4*)(G + (size_t)item * 4096) + lane * 4;
#pragma unroll
    for (int q = 0; q < 4; ++q) {
        gp[q] = (f32x4){st00[4 * q], st00[4 * q + 1], st00[4 * q + 2], st00[4 * q + 3]}; gp[256 + q] = (f32x4){st01[4 * q], st01[4 * q + 1], st01[4 * q + 2], st01[4 * q + 3]};
        gp[512 + q] = (f32x4){st10[4 * q], st10[4 * q + 1], st10[4 * q + 2], st10[4 * q + 3]}; gp[768 + q] = (f32x4){st11[4 * q], st11[4 * q + 1], st11[4 * q + 2], st11[4 * q + 3]}; }
}

template <int PREFIX_ONLY> DI void ret2_unit(int item2, const bf16_t* __restrict__ P, const bf16_t* __restrict__ T, const float* __restrict__ G, bf16_t* __restrict__ Y,
                  const float* __restrict__ gain, int lane, LAS unsigned char* wl) {
    const int it = item2 & 1, item = item2 >> 1;
    const int g = item % NG, bh = item / NG, b = bh >> 2, h = bh & 3;
    const unsigned n0_ = lane & 31, hi0_ = lane >> 5;
    const float lg = lgamma2(h);
    const float cd = EXP2(lg * 64.0f), cdG = EXP2(lg * (64.0f * GC));
    f32x16 st00 = zero16(), st01 = zero16(), st10 = zero16(), st11 = zero16();
    if (g > 0) {
        const f32x4* sp = (const f32x4*)(G + (size_t)(bh * NG + g) * 4096) + lane * 4;
#pragma unroll
        for (int q = 0; q < 4; ++q) { const f32x4 a0 = sp[q], a1 = sp[256 + q], a2 = sp[512 + q], a3 = sp[768 + q];
#pragma unroll
            for (int e = 0; e < 4; ++e) { st00[4 * q + e] = a0[e]; st01[4 * q + e] = a1[e]; st10[4 * q + e] = a2[e]; st11[4 * q + e] = a3[e]; } }
    }
    if (PREFIX_ONLY == 1) { if (st00[0] + st01[1] + st10[2] + st11[3] == 12345.678f) Y[0] = 0; return; }
    const float* gn = gain + h * 64;
#pragma unroll 1
    for (int c = 0; c < (PREFIX_ONLY == 2 ? 1 : GC); ++c) {
        const size_t tb = (size_t)b * SEQ + (size_t)(g * GC + c) * 64;
        const bf16_t* Pq = P + tb * PW + P_QR + h * 64; const bf16_t* Pk = P + tb * PW + P_KR + h * 64; const bf16_t* Pg = P + tb * PW + P_GR + h * 64;
        bf16_t* Yb = Y + tb * DM + Y_R + h * 64; const bf16_t* Tv = T + (size_t)(T_VR + h * 64) * LDT + tb;
        RET_STAGE(wl, Pk, PW); RET_STAGE(wl + 8192, Tv, LDT);
        u32x4 gr[4], ktr[8];
        RET_STAGE_LOAD(gr, 4, Pg + (size_t)(32 * it) * PW, PW);
        if (c + 1 < GC) RET_STAGE_LOAD(ktr, 8, T + (size_t)(T_KR + h * 64) * LDT + tb, LDT);
        {
            unsigned n = n0_, hi = hi0_; asm volatile("" : "+v"(n), "+v"(hi));
            const unsigned ov = n * (unsigned)LDT + 4u * hi;
            const unsigned il = 32u * it + n, oq = il * PW;
            f32x16 y0 = zero16(), y1 = zero16();
            { const bfx8 q0 = ld44(Pq + (oq + 4 * hi)), q1 = ld44(Pq + (oq + 16 + 4 * hi)), q2 = ld44(Pq + (oq + 32 + 4 * hi)), q3 = ld44(Pq + (oq + 48 + 4 * hi));
              y0 = MFMA32(pack8<0>(st00), q0, y0); y1 = MFMA32(pack8<0>(st01), q0, y1);
              y0 = MFMA32(pack8<1>(st00), q1, y0); y1 = MFMA32(pack8<1>(st01), q1, y1);
              y0 = MFMA32(pack8<0>(st10), q2, y0); y1 = MFMA32(pack8<0>(st11), q2, y1);
              y0 = MFMA32(pack8<1>(st10), q3, y0); y1 = MFMA32(pack8<1>(st11), q3, y1); }

            const float qdec = EXP2(lg * (float)(il + 1));
            y0 *= qdec; y1 *= qdec;
            f32x16 sc0 = zero16(), sc1 = zero16();
            { const unsigned ok = n * PW + 8 * hi;
#pragma unroll
              for (int kk = 0; kk < 4; ++kk) { const bfx8 qn = ld8(Pq + (oq + 16 * kk + 8 * hi)); const bfx8 k0 = RET_FRAG(wl, n, 2 * kk + hi), k1 = RET_FRAG(wl, 32 + n, 2 * kk + hi);
                  sc0 = MFMA32(k0, qn, sc0); sc1 = MFMA32(k1, qn, sc1);  } }

#pragma unroll
            for (int i = 0; i < 16; ++i) { const int j0 = crow(i, hi); sc0[i] *= EXP2(lg * fabsf((float)((int)il - j0))); sc1[i] *= EXP2(lg * fabsf((float)((int)il - j0 - 32))); }
            { const LAS unsigned char* vimg = wl + 8192;
              { const bfx8 w = pack8<0>(sc0); y0 = MFMA32(lds44(vimg, n, 0, hi), w, y0); y1 = MFMA32(lds44(vimg, 32 + n, 0, hi), w, y1); }
              { const bfx8 w = pack8<1>(sc0); y0 = MFMA32(lds44(vimg, n, 1, hi), w, y0); y1 = MFMA32(lds44(vimg, 32 + n, 1, hi), w, y1); }
              { const bfx8 w = pack8<0>(sc1); y0 = MFMA32(lds44(vimg, n, 2, hi), w, y0); y1 = MFMA32(lds44(vimg, 32 + n, 2, hi), w, y1); }
              { const bfx8 w = pack8<1>(sc1); y0 = MFMA32(lds44(vimg, n, 3, hi), w, y0); y1 = MFMA32(lds44(vimg, 32 + n, 3, hi), w, y1); } }
            float sum = 0.f;
#pragma unroll
            for (int i = 0; i < 16; ++i) sum += y0[i] + y1[i];
            sum += __shfl_xor(sum, 32);
            const float mean = sum * (1.0f / 64.0f);
            float sq = 0.f;
#pragma unroll
            for (int i = 0; i < 16; ++i) { y0[i] -= mean; y1[i] -= mean; sq += y0[i] * y0[i] + y1[i] * y1[i]; }
            sq += __shfl_xor(sq, 32);
            const float rs = 1.0f / sqrtf(sq * (1.0f / 64.0f) + 1e-6f);
            { const int srow = lane >> 3, sch = lane & 7;
              RET_STAGE_STORE(wl, gr, 4);
#pragma unroll
              for (int q = 0; q < 4; ++q) {
                { const u32x2 gv = *(const LAS u32x2*)(wl + n * 128 + (((q) ^ ((n >> 1) & 7)) << 4) + 8 * hi); const f32x4 gg = *(const f32x4*)(gn + (4 * hi + 8 * q));
                  const float g0 = bf_lo(gv.x), g1 = bf_hi(gv.x), g2 = bf_lo(gv.y), g3 = bf_hi(gv.y);
                  u32x2 o; o.x = pk2(y0[4 * q] * rs * gg[0] * (g0 * pg8::sigmoid_f(g0)), y0[4 * q + 1] * rs * gg[1] * (g1 * pg8::sigmoid_f(g1)));
                  o.y = pk2(y0[4 * q + 2] * rs * gg[2] * (g2 * pg8::sigmoid_f(g2)), y0[4 * q + 3] * rs * gg[3] * (g3 * pg8::sigmoid_f(g3)));
                  *(LAS u32x2*)(wl + 4096 + n * 128 + (((q) ^ ((n >> 1) & 7)) << 4) + 8 * hi) = o; }
                { const u32x2 gv = *(const LAS u32x2*)(wl + n * 128 + (((4 + q) ^ ((n >> 1) & 7)) << 4) + 8 * hi); const f32x4 gg = *(const f32x4*)(gn + (4 * hi + 32 + 8 * q));
                  const float g0 = bf_lo(gv.x), g1 = bf_hi(gv.x), g2 = bf_lo(gv.y), g3 = bf_hi(gv.y);
                  u32x2 o; o.x = pk2(y1[4 * q] * rs * gg[0] * (g0 * pg8::sigmoid_f(g0)), y1[4 * q + 1] * rs * gg[1] * (g1 * pg8::sigmoid_f(g1)));
                  o.y = pk2(y1[4 * q + 2] * rs * gg[2] * (g2 * pg8::sigmoid_f(g2)), y1[4 * q + 3] * rs * gg[3] * (g3 * pg8::sigmoid_f(g3)));
                  *(LAS u32x2*)(wl + 4096 + n * 128 + (((4 + q) ^ ((n >> 1) & 7)) << 4) + 8 * hi) = o; }
              }
              bf16_t* yg = Yb + (size_t)(32 * it + srow) * DM + 8 * sch;
#pragma unroll
              for (int i = 0; i < 4; ++i) { const int r = 8 * i + srow; *(u32x4*)(yg + (size_t)(8 * i) * DM) = *(const LAS u32x4*)(wl + 4096 + r * 128 + ((sch ^ ((r >> 1) & 7)) << 4)); }
            }
        }
        if (c + 1 < GC) { unsigned n = n0_, hi = hi0_; asm volatile("" : "+v"(n), "+v"(hi)); st00 *= cd; st01 *= cd; st10 *= cd; st11 *= cd;
            RET_STAGE_STORE(wl, ktr, 8); RET_UPDATE(wl, wl + 8192); }
    }
}

struct TrItem { const float* src; const float* gain; bf16_t* dst; int N, K, k0, drow0; };
DI void tr_load(const TrItem& t, float (&v)[32], int lane) {
    const float* p = t.src + (size_t)(t.k0 + (lane >> 5)) * t.N + (lane & 31);
#pragma unroll
    for (int i = 0; i < 32; ++i) v[i] = __builtin_nontemporal_load(p + (size_t)(2 * i) * t.N);
}
DI void tr_store(const TrItem& t, const float (&v)[32], LAS float* scr, int lane) {
#pragma unroll
    for (int i = 0; i < 32; ++i) scr[(2 * i + (lane >> 5)) * 33 + (lane & 31)] = v[i];
    asm volatile("s_waitcnt lgkmcnt(0)" ::: "memory");
    const int c = lane & 7;
    f32x4 g0 = {1.f, 1.f, 1.f, 1.f}, g1 = g0;
    if (t.gain) { g0 = *(const f32x4*)(t.gain + t.k0 + 8 * c); g1 = *(const f32x4*)(t.gain + t.k0 + 8 * c + 4); }
#pragma unroll
    for (int j = 0; j < 4; ++j) { const int nn = (lane >> 3) + 8 * j; const LAS float* s = scr + (8 * c) * 33 + nn;
        u32x4 o; o.x = pk2(s[0 * 33] * g0[0], s[1 * 33] * g0[1]); o.y = pk2(s[2 * 33] * g0[2], s[3 * 33] * g0[3]); o.z = pk2(s[4 * 33] * g1[0], s[5 * 33] * g1[1]); o.w = pk2(s[6 * 33] * g1[2], s[7 * 33] * g1[3]);
        *(u32x4*)(t.dst + (size_t)(t.drow0 + nn) * t.K + t.k0 + 8 * c) = o; }
    asm volatile("s_waitcnt lgkmcnt(0)" ::: "memory");
}
DI int srcmap(int type, int n0) {
    const int tile = n0 >> 8, c = n0 & 255, bj = c >> 7, p = c & 127;
    if (type == 0) return bj * FF + 128 * tile + p;
    if (type == 1) return n0;
    if (type == 2) {
        if (tile < 2) return bj * 256 + 128 * tile + p;
        if (tile < 6) return 512 + 256 * (tile - 2) + c;
        if (tile == 6) return 2048 + (p >> 5) * 64 + 32 * bj + (p & 31);
        if (tile == 7) return 2304 + (p >> 5) * 64 + 32 * bj + (p & 31);
        return 2816 + c;
    }
    if (tile < 2) return 1536 + n0;
    if (tile == 2) return 2560 + c;
    return 2304 + (p >> 5) * 64 + 32 * bj + (p & 31);
}

#define XB_TMO      128
#define XB_XCNT(j)  (256  + 64 * (j))
#define XB_XSUB(j)  (1280 + 64 * (j))
#define XB_XGEN(j)  (2304 + 64 * (j))
#define XB_TOP      3328
#define XB_TOPGEN   3392
#define XCD_BAR_WORDS 3456
#define XB_SPIN_CAP (1u << 18)

__device__ __forceinline__ unsigned xb_ld(unsigned* p)              { return __hip_atomic_load(p, __ATOMIC_RELAXED, __HIP_MEMORY_SCOPE_AGENT); }
__device__ __forceinline__ unsigned xb_add(unsigned* p, unsigned v) { return __hip_atomic_fetch_add(p, v, __ATOMIC_RELAXED, __HIP_MEMORY_SCOPE_AGENT); }
__device__ __forceinline__ unsigned xb_xcc_id() { return (unsigned)__builtin_amdgcn_s_getreg((3 << 11) | 20) & 0xFu; }
#define XB_SPIN(cond, bar) do { unsigned _sp = 0; while (cond) { __builtin_amdgcn_s_sleep(1); \
    if ((++_sp & 255u) == 0u) { if (xb_ld(&(bar)[XB_TMO])) break; if (_sp > XB_SPIN_CAP) { atomicAdd(&(bar)[XB_TMO], 1u); break; } } } } while (0)

struct XcdBarrier {
    unsigned* bar; unsigned x;
    volatile LAS unsigned* st;
};

__device__ __forceinline__ XcdBarrier xcd_barrier_post(unsigned* bar, volatile LAS unsigned* st) {
    XcdBarrier b; b.bar = bar; b.x = xb_xcc_id(); b.st = st;
    if (threadIdx.x == 0) (void)xb_add(&bar[XB_XCNT(b.x)], 1u);
    return b;
}
__device__ __forceinline__ void xcd_barrier_complete(unsigned* bar, unsigned x, unsigned& nloc, unsigned& nx) {
    const unsigned G = gridDim.x * gridDim.y * gridDim.z;
    unsigned sum, cnt, mine, sp = 0u;
    for (;;) {
        sum = 0u; cnt = 0u; mine = 0u;
#pragma unroll
        for (unsigned j = 0; j < 16; ++j) { const unsigned c = xb_ld(&bar[XB_XCNT(j)]); sum += c; cnt += (c > 0u) ? 1u : 0u; mine = (j == x) ? c : mine; }
        if (sum == G) break;
        __builtin_amdgcn_s_sleep(1);
        if ((++sp & 255u) == 0u) { if (xb_ld(&bar[XB_TMO])) break; if (sp > XB_SPIN_CAP) { atomicAdd(&bar[XB_TMO], 1u); break; } }
    }
    nloc = mine > 0u ? mine : 1u; nx = cnt > 0u ? cnt : 1u;
}

__device__ __forceinline__ void xcd_barrier(const XcdBarrier& b) {
    asm volatile("s_waitcnt vmcnt(0)" ::: "memory");
    __syncthreads();
    if (threadIdx.x == 0) {
        unsigned* bar = b.bar;
        __builtin_amdgcn_s_waitcnt(0);
        unsigned nloc = b.st[0], nx = b.st[1];
        if (nloc == 0u) { xcd_barrier_complete(bar, b.x, nloc, nx); b.st[0] = nloc; b.st[1] = nx; }
        const unsigned old = xb_add(&bar[XB_XSUB(b.x)], 1u);
        const unsigned gen = old / nloc;
        if (old + 1u == (gen + 1u) * nloc) {
            __builtin_amdgcn_fence(__ATOMIC_RELEASE, "agent");
            asm volatile("s_waitcnt vmcnt(0)" ::: "memory");
            const unsigned og = xb_add(&bar[XB_TOP], 1u);
            const unsigned tg = og / nx;
            if (og + 1u == (tg + 1u) * nx) xb_add(&bar[XB_TOPGEN], 1u);
            else XB_SPIN(xb_ld(&bar[XB_TOPGEN]) == tg, bar);
            __builtin_amdgcn_fence(__ATOMIC_ACQUIRE, "agent");
            xb_add(&bar[XB_XGEN(b.x)], 1u);
            asm volatile("s_waitcnt vmcnt(0)" ::: "memory");
        } else {
            XB_SPIN(xb_ld(&bar[XB_XGEN(b.x)]) == gen, bar);
            __builtin_amdgcn_fence(__ATOMIC_ACQUIRE, "agent");
            asm volatile("s_waitcnt vmcnt(0)" ::: "memory");
        }
    }
    __syncthreads();
}

#ifdef NO_R1
#define DO_R1(...)
#else
#define DO_R1(...) __VA_ARGS__
#endif
#ifdef NO_R2
#define DO_R2(...)
#else
#define DO_R2(...) __VA_ARGS__
#endif
#ifdef NO_SB
#define DO_SB(...)
#else
#define DO_SB(...) __VA_ARGS__
#endif
#ifdef NO_CV
#define DO_CV(...)
#else
#define DO_CV(...) __VA_ARGS__
#endif
#ifdef NO_G0
#define DO_G0(...)
#else
#define DO_G0(...) __VA_ARGS__
#endif
#ifdef NO_G1
#define DO_G1(...)
#else
#define DO_G1(...) __VA_ARGS__
#endif
#ifdef NO_G2
#define DO_G2(...)
#else
#define DO_G2(...) __VA_ARGS__
#endif
#ifdef NO_G3
#define DO_G3(...)
#else
#define DO_G3(...) __VA_ARGS__
#endif

#ifndef P2_PROBE
#define P2_PROBE 3
#endif
#ifndef MI_PROBE
#define MI_PROBE 3
#endif
#ifndef PRO_PART
#define PRO_PART 7
#endif
struct Args { const float* in[16]; float* out; unsigned char* ws; int ph_lo, ph_hi; };
constexpr int PPL = 9, N_PHASES = 2 + PPL * DEPTH;
constexpr int RS_OFF = 131072;

constexpr int RS_SLOTS = 12;
DI void fill_rowscales(const pg8::StaticOrder& S, const float* SS, LAS float* rs, int bycol) {
    pg8::Unit u;
    for (int ui = 0; ui < RS_SLOTS && S.next(ui, u); ++ui) {
        const int t = threadIdx.x;
        if (t < 256) rs[ui * 256 + t] = pg8::rowscale(SS, (bycol ? u.pn : u.pm) * 256 + t);
    }
    __syncthreads();
}

DI TrItem tr_decode(const Args& a, unsigned char* ws, int it) {
    constexpr int I0 = 16 * (NFF / 32), I1 = (FF / 64) * 32, I2 = 16 * 72, I3 = 16 * 32, I4 = 16 * 32, IL = 2 * I0 + 2 * I1 + I2 + I3 + I4;
    const int l = it / IL; int r = it % IL;
    unsigned char* wb = ws + WS_W + (size_t)l * W_STRIDE;
    TrItem t; int type, nblk;
    if (r < I0) { t.src = a.in[2] + (size_t)l * DM * NFF; t.gain = a.in[1] + l * DM; t.dst = (bf16_t*)(wb + WO_1I); t.N = NFF; t.K = DM; type = 0; nblk = NFF / 32; }
    else if ((r -= I0) < I1) { t.src = a.in[3] + (size_t)l * FF * DM; t.gain = nullptr; t.dst = (bf16_t*)(wb + WO_1O); t.N = DM; t.K = FF; type = 1; nblk = 32; }
    else if ((r -= I1) < I2) { t.src = a.in[5] + (size_t)l * DM * NMIX; t.gain = a.in[4] + l * DM; t.dst = (bf16_t*)(wb + WO_MN); t.N = NMIX; t.K = DM; type = 2; nblk = 72; }
    else if ((r -= I2) < I3) { t.src = a.in[5] + (size_t)l * DM * NMIX; t.gain = a.in[4] + l * DM; t.dst = (bf16_t*)(wb + WO_MT); t.N = NMIX; t.K = DM; type = 3; nblk = 32; }
    else if ((r -= I3) < I4) { t.src = a.in[11] + (size_t)l * DM * DM; t.gain = nullptr; t.dst = (bf16_t*)(wb + WO_MO); t.N = DM; t.K = DM; type = 1; nblk = 32; }
    else if ((r -= I4) < I0) { t.src = a.in[13] + (size_t)l * DM * NFF; t.gain = a.in[12] + l * DM; t.dst = (bf16_t*)(wb + WO_2I); t.N = NFF; t.K = DM; type = 0; nblk = NFF / 32; }
    else { r -= I0; t.src = a.in[14] + (size_t)l * FF * DM; t.gain = nullptr; t.dst = (bf16_t*)(wb + WO_2O); t.N = DM; t.K = FF; type = 1; nblk = 32; }
    const int kb = r / nblk, nb = r % nblk;
    t.src += srcmap(type, nb * 32); t.drow0 = nb * 32; t.k0 = kb * 64;
    return t;
}

template <int PH, int REP = 0> DI void run_phase(const Args& a, LAS unsigned char* lds, const int lane, const int wave) {
    const int G = gridDim.x, gw = blockIdx.x * NWAVES + wave, NGW = G * NWAVES;
    unsigned char* ws = a.ws;
    LAS float* rs = (LAS float*)(lds + RS_OFF);
    if constexpr (PH == 0) {
        LAS float* scr = (LAS float*)(lds + wave * 16384);
        constexpr int I0 = 16 * (NFF / 32), I1 = (FF / 64) * 32, I2 = 16 * 72, I3 = 16 * 32, I4 = 16 * 32, IL = 2 * I0 + 2 * I1 + I2 + I3 + I4;
        if (!REP || (PRO_PART & 1)) {
            float va[32], vb[32];
            int it = gw;
            TrItem ta{}, tb{};
            if (it < DEPTH * IL) { ta = tr_decode(a, ws, it); tr_load(ta, va, lane); }
            while (it < DEPTH * IL) {
                const int itb = it + NGW, ita = it + 2 * NGW;
                if (itb < DEPTH * IL) { tb = tr_decode(a, ws, itb); tr_load(tb, vb, lane); }
                tr_store(ta, va, scr, lane);
                if (itb >= DEPTH * IL) break;
                if (ita < DEPTH * IL) { ta = tr_decode(a, ws, ita); tr_load(ta, va, lane); }
                tr_store(tb, vb, scr, lane);
                it = ita;
            }
        }
        { float* SS = (float*)(ws + WS_SS); bf16_t* XB = (bf16_t*)(ws + WS_XB);
          if (!REP || (PRO_PART & 2)) for (int m = gw; m < M_TOK; m += NGW) {
            const f32x4* xr = (const f32x4*)(a.in[0] + (size_t)m * DM) + lane; float s = 0.f;
            unsigned long long* o8 = (unsigned long long*)(XB + (size_t)m * DM) + lane;
#pragma unroll
            for (int j = 0; j < 4; ++j) { const f32x4 v = __builtin_nontemporal_load(xr + 64 * j); s += (v[0] * v[0] + v[1] * v[1]) + (v[2] * v[2] + v[3] * v[3]);
                o8[64 * j] = (unsigned long long)pk2(v[0], v[1]) | ((unsigned long long)pk2(v[2], v[3]) << 32); }
            s = wave_sum(s);
            if (lane < 16) SS[(size_t)m * 16 + lane] = (lane == 0) ? s : 0.f;
          } }
        { float* cosT = (float*)(ws + WS_ROT); float* sinT = cosT + 262144; float* cosTT = sinT + 262144; float* sinTT = cosTT + 262144;
          if (!REP || (PRO_PART & 4)) for (int idx = blockIdx.x * NTHR + threadIdx.x; idx < 262144; idx += G * NTHR) {
            const int pos = idx >> 5, dd = idx & 31;
            double inv = 0.15915494309189535;
            for (int q = 0; q < dd; ++q) inv *= 0.7498942093324558;
            const double rev = (double)pos * inv; const float fr = (float)(rev - __builtin_floor(rev));
            const float cv = __builtin_amdgcn_cosf(fr), sv = __builtin_amdgcn_sinf(fr);
            cosT[idx] = cv; sinT[idx] = sv; cosTT[dd * 8192 + pos] = cv; sinTT[dd * 8192 + pos] = sv;
          } }
    } else if constexpr (PH == N_PHASES - 1) {
        const float* fg = a.in[15]; const float* SS = (const float*)(ws + WS_SS); float* X = a.out; const bf16_t* XB = (const bf16_t*)(ws + WS_XB);
        for (int m = gw; m < M_TOK; m += NGW) {
            const float r = pg8::rowscale(SS, m);
            const u32x2* xr = (const u32x2*)(XB + (size_t)m * DM) + lane; f32x4* orow = (f32x4*)(X + (size_t)m * DM) + lane; const f32x4* gr = (const f32x4*)fg + lane;
#pragma unroll
            for (int j = 0; j < 4; ++j) { const u32x2 w = xr[64 * j]; const f32x4 v = {bf_lo(w.x), bf_hi(w.x), bf_lo(w.y), bf_hi(w.y)}; __builtin_nontemporal_store(v * r * gr[64 * j], orow + 64 * j); }
        }
    } else {
        constexpr int l = (PH - 1) / PPL, s = (PH - 1) % PPL;
        unsigned char* wb = ws + WS_W + (size_t)l * W_STRIDE;
        if constexpr (s == 0 || s == 7) {
            pg8::Gemm g{(const bf16_t*)(ws + WS_XB), (const bf16_t*)(wb + (s == 0 ? WO_1I : WO_2I)), M_TOK, NFF, DM};
            pg8::StaticOrder S; S.init(M_TOK, NFF, G, (int)blockIdx.x); fill_rowscales(S, (const float*)(ws + WS_SS), rs, 0);
            pg8::EpiSwiGLU E{(bf16_t*)(ws + WS_H), rs, FF};
            DO_G0(pg8::gemm_phase<pg8::EpiSwiGLU, pg8::StaticOrder, true, true>(lds, g, S, E));
        } else if constexpr (s == 1 || s == 6 || s == 8) {
            pg8::Gemm g{(const bf16_t*)(ws + (s == 6 ? WS_Y : WS_H)), (const bf16_t*)(wb + (s == 1 ? WO_1O : s == 6 ? WO_MO : WO_2O)), M_TOK, DM, (s == 6) ? DM : FF};
            pg8::StaticOrder S; S.init(M_TOK, DM, G, (int)blockIdx.x);
            pg8::EpiResid E{(bf16_t*)(ws + WS_XB), (float*)(ws + WS_SS), (s == 6) ? 1.0f : 0.5f};
            DO_G1(pg8::gemm_phase<pg8::EpiResid, pg8::StaticOrder, true, true>(lds, g, S, E));
        } else if constexpr (s == 2) {
            const float* cosT = (const float*)(ws + WS_ROT);
            { pg8::Gemm g{(const bf16_t*)(ws + WS_XB), (const bf16_t*)(wb + WO_MN), M_TOK, 2304, DM};
              pg8::StaticOrder S; S.init(M_TOK, 2304, G, (int)blockIdx.x); fill_rowscales(S, (const float*)(ws + WS_SS), rs, 0);
              pg8::EpiMixN E{(bf16_t*)(ws + WS_H), rs, cosT, cosT + 262144, PW};
              if (!REP || (MI_PROBE & 1)) DO_G2(pg8::gemm_phase<pg8::EpiMixN, pg8::StaticOrder, true, true>(lds, g, S, E)); }
            { pg8::Gemm g{(const bf16_t*)(wb + WO_MT), (const bf16_t*)(ws + WS_XB), 1024, M_TOK, DM};
              pg8::StaticOrder S; S.init(1024, M_TOK, G, (int)blockIdx.x); __syncthreads(); fill_rowscales(S, (const float*)(ws + WS_SS), rs, 1);
              pg8::EpiMixT E{(bf16_t*)(ws + WS_T), rs, cosT + 2 * 262144, cosT + 3 * 262144, LDT};
              if (!REP || (MI_PROBE & 2)) DO_G3(pg8::gemm_phase<pg8::EpiMixT, pg8::StaticOrder, true, true>(lds, g, S, E)); }
        } else if constexpr (s == 3) {
            constexpr int N_R1 = 16 * NG, N_SB = SB_PART1, N_CV = M_TOK / 16, NTOT = N_R1 + N_SB + N_CV;
            const bf16_t* P = (const bf16_t*)(ws + WS_H); const bf16_t* T = (const bf16_t*)(ws + WS_T); bf16_t* Y = (bf16_t*)(ws + WS_Y);
            if (N_SB == 0 && NWAVES == 8 && 8 * G == N_CV && 2 * G == N_R1) {
                const int bid = (G % 8 == 0) ? ((int)blockIdx.x % 8) * (G / 8) + (int)blockIdx.x / 8 : (int)blockIdx.x;
                if (wave < 2) { int ln = lane; asm volatile("" : "+v"(ln) :: "memory"); DO_R1(ret1_unit(bid * 2 + wave, T, (float*)(ws + WS_G), ln, lds + wave * 16384)); }
                { int ln = lane; asm volatile("" : "+v"(ln) :: "memory"); DO_CV(conv_unit(bid * 8 + wave, P, Y, a.in[6] + l * 31 * 256, a.in[7] + l * 256, a.in[8] + l * 256, a.in[9] + l * 256, ln)); }
            } else {
            const int gwp = wave * G + (int)blockIdx.x;
            for (int it = gwp; it < NTOT; it += NGW) {
                int ln = lane; asm volatile("" : "+v"(ln) :: "memory");
                if (it < N_R1) { DO_R1(ret1_unit(it, T, (float*)(ws + WS_G), ln, lds + wave * 16384)); }
                else if (it < N_R1 + N_SB) { DO_SB(sb_unit(it - N_R1, P, T, Y, ln, lds + wave * 16384)); }
                else { DO_CV(conv_unit(it - N_R1 - N_SB, P, Y, a.in[6] + l * 31 * 256, a.in[7] + l * 256, a.in[8] + l * 256, a.in[9] + l * 256, ln)); }
            }
            }
        } else if constexpr (s == 4) {
            const float* GB = (const float*)(ws + WS_G); float* SP = (float*)(ws + WS_SP);
            for (int idx = blockIdx.x * NTHR + threadIdx.x; idx < 16 * 4096; idx += G * NTHR) {
                const int bh = idx >> 12, e = idx & 4095;
                const float cdG = EXP2(lgamma2(bh & 3) * (64.0f * GC));
                const float* gp = GB + (size_t)(bh * NG) * 4096 + e; float* sp = SP + (size_t)(bh * NG) * 4096 + e;
                float v[NG - 1];
#pragma unroll
                for (int g = 0; g < NG - 1; ++g) v[g] = gp[(size_t)g * 4096];
                float st = 0.f;
#pragma unroll
                for (int g = 0; g < NG - 1; ++g) { st = st * cdG + v[g]; sp[(size_t)(g + 1) * 4096] = st; }
            }
        } else {
            constexpr int N_R2 = 2 * 16 * NG, N_SB = 4096 - SB_PART1;
            const bf16_t* P = (const bf16_t*)(ws + WS_H); const bf16_t* T = (const bf16_t*)(ws + WS_T); bf16_t* Y = (bf16_t*)(ws + WS_Y);
            if (NWAVES == 8 && NGW >= 2048) {
                const int bid = (G % 8 == 0) ? ((int)blockIdx.x % 8) * (G / 8) + (int)blockIdx.x / 8 : (int)blockIdx.x;
                if (wave < 4) {
                    for (int it = bid * 4 + wave; it < N_R2; it += 4 * G) {
                        int ln = lane; asm volatile("" : "+v"(ln) :: "memory");
                        if (!REP || (P2_PROBE & 1)) DO_R2(ret2_unit<(REP && (P2_PROBE & 4)) ? 1 : (REP && (P2_PROBE & 8)) ? 2 : 0>(it, P, T, (const float*)(ws + WS_SP), Y, a.in[10] + l * 256, ln, lds + wave * 16384));
                    }
                    const int nmain = 12 * G < N_SB ? 12 * G : N_SB;
                    if (!REP || (P2_PROBE & 2)) for (int it = nmain + bid * 4 + wave; it < N_SB; it += 4 * G) {
                        int ln = lane; asm volatile("" : "+v"(ln) :: "memory");
                        DO_SB(sb_unit(SB_PART1 + it, P, T, Y, ln, lds + wave * 16384));
                    }
                } else {
                    const int nmain = 12 * G < N_SB ? 12 * G : N_SB;
                    if (!REP || (P2_PROBE & 2)) for (int k = 0; k < 3; ++k) {
                        const int it = bid * 12 + 4 * k + (wave - 4);
                        if (it < nmain) { int ln = lane; asm volatile("" : "+v"(ln) :: "memory"); DO_SB(sb_unit(SB_PART1 + it, P, T, Y, ln, lds + wave * 16384)); }
                    }
                    if (12 * G < N_SB && G * 4 < N_SB - 12 * G) {
                        for (int it = 12 * G + 4 * G + bid * 4 + (wave - 4); it < N_SB; it += 4 * G) { int ln = lane; asm volatile("" : "+v"(ln) :: "memory"); DO_SB(sb_unit(SB_PART1 + it, P, T, Y, ln, lds + wave * 16384)); }
                    }
                }
            } else {
                const int gwp = wave * G + (int)blockIdx.x;
                for (int it = gwp; it < N_R2; it += NGW) { int ln = lane; asm volatile("" : "+v"(ln) :: "memory"); DO_R2(ret2_unit<0>(it, P, T, (const float*)(ws + WS_SP), Y, a.in[10] + l * 256, ln, lds + wave * 16384)); }
                for (int it = gwp; it < N_SB; it += NGW) { int ln = lane; asm volatile("" : "+v"(ln) :: "memory"); DO_SB(sb_unit(SB_PART1 + it, P, T, Y, ln, lds + wave * 16384)); }
            }
        }
    }
}

__global__ void __launch_bounds__(NTHR, 2) mk_fwd(Args a) {
    extern __shared__ __attribute__((aligned(16))) unsigned char lds_raw[];
    LAS unsigned char* lds = (LAS unsigned char*)lds_raw;
    cg::grid_group grid = cg::this_grid();
    const int lane = threadIdx.x & 63, wave = __builtin_amdgcn_readfirstlane(threadIdx.x >> 6);
    const int lo = a.ph_lo, hi = a.ph_hi;
    volatile LAS unsigned* bst = (volatile LAS unsigned*)(lds + RS_OFF + RS_SLOTS * 1024);
    if (threadIdx.x < 2) bst[threadIdx.x] = 0u;
    __syncthreads();
    XcdBarrier bar; bar.bar = (unsigned*)(a.ws + WS_CTL) + 4096; bar.x = 0; bar.st = bst;
#ifndef REP_MASK
#define REP_MASK 0
#endif
    if (hi - lo > 1) {
        if (blockIdx.x == 0) for (int i = threadIdx.x; i < XCD_BAR_WORDS; i += NTHR) __hip_atomic_store((unsigned*)(a.ws + WS_CTL) + 4096 + i, 0u, __ATOMIC_RELAXED, __HIP_MEMORY_SCOPE_AGENT);
        __threadfence();
        grid.sync();
        bar = xcd_barrier_post((unsigned*)(a.ws + WS_CTL) + 4096, bst);
    }
#define SEAM(k) xcd_barrier(bar)
#define PHASE(k) if (lo <= (k) && (k) < hi) { if ((k) > lo) SEAM(k); run_phase<(k)>(a, lds, lane, wave); if constexpr ((REP_MASK >> (k)) & 1) { xcd_barrier(bar); run_phase<(k), 1>(a, lds, lane, wave); } }
    PHASE(0)
#ifdef EXTRA_SYNCS
    for (int i = 0; i < EXTRA_SYNCS; ++i) xcd_barrier(bar);
#endif
    PHASE(1) PHASE(2) PHASE(3) PHASE(4) PHASE(5) PHASE(6) PHASE(7) PHASE(8) PHASE(9) PHASE(10) PHASE(11) PHASE(12) PHASE(13) PHASE(14) PHASE(15) PHASE(16) PHASE(17) PHASE(18) PHASE(19)
#undef PHASE
}

#ifndef MK_SPLIT
#define MK_SPLIT 0
#endif
extern "C" void kernel_launch(void* const* d_in, const int* in_sizes, int n_in, void* d_out, int out_size, void* d_ws, size_t ws_size, hipStream_t stream) {
    static int grid = 0;
    if (grid == 0) {
        if (n_in != 16 || in_sizes[0] != M_TOK * DM || out_size != M_TOK * DM || ws_size < WS_END) { fprintf(stderr, "kernel_launch: unexpected shapes (n_in %d, in0 %d, out %d, ws %zu)\n", n_in, n_in > 0 ? in_sizes[0] : -1, out_size, ws_size); grid = -1; return; }
        int dev = 0, cus = 0, per_cu = 0;
        if (hipGetDevice(&dev) != hipSuccess || hipDeviceGetAttribute(&cus, hipDeviceAttributeMultiprocessorCount, dev) != hipSuccess) { grid = -1; return; }
        if (hipFuncSetAttribute((const void*)mk_fwd, hipFuncAttributeMaxDynamicSharedMemorySize, LDS_BYTES) != hipSuccess) { fprintf(stderr, "kernel_launch: hipFuncSetAttribute failed\n"); grid = -1; return; }
        if (hipOccupancyMaxActiveBlocksPerMultiprocessor(&per_cu, (const void*)mk_fwd, NTHR, LDS_BYTES) != hipSuccess || per_cu < 1) { fprintf(stderr, "kernel_launch: occupancy query says %d\n", per_cu); per_cu = 1; }
        (void)hipGetLastError();
        grid = cus * 1;
        if (grid * RS_SLOTS < 2816) { fprintf(stderr, "kernel_launch: %d CUs: the row-scale slots are sized for >= 235 workgroups; nothing launched\n", grid); grid = -1; return; }
    }
    if (grid < 0) return;
    Args a{};
    for (int i = 0; i < 16; ++i) a.in[i] = (const float*)d_in[i];
    a.out = (float*)d_out; a.ws = (unsigned char*)d_ws;
#if MK_SPLIT
    for (int ph = 0; ph < N_PHASES; ++ph) {
        a.ph_lo = ph; a.ph_hi = ph + 1; void* args[] = {&a};
        hipError_t e = hipLaunchCooperativeKernel((const void*)mk_fwd, dim3(grid), dim3(NTHR), args, LDS_BYTES, stream);
        if (e != hipSuccess) { fprintf(stderr, "kernel_launch: launch %d failed: %s\n", ph, hipGetErrorString(e)); break; }
    }
#else
    a.ph_lo = 0; a.ph_hi = N_PHASES; void* args[] = {&a};
    hipError_t e = hipLaunchCooperativeKernel((const void*)mk_fwd, dim3(grid), dim3(NTHR), args, LDS_BYTES, stream);
    if (e != hipSuccess) fprintf(stderr, "kernel_launch: cooperative launch failed: %s (grid %d)\n", hipGetErrorString(e), grid);
#endif
}
```

```cpp
#ifndef MK_SPLIT
#define MK_SPLIT 0
#endif
#include <hip/hip_runtime.h>
#include <hip/hip_cooperative_groups.h>
#include <cstdio>
#include <cstdint>
namespace cg = cooperative_groups;
namespace pg8 {
#define PG8_LAS __attribute__((address_space(3)))
typedef unsigned short bf16_t;
typedef short bf16x8 __attribute__((ext_vector_type(8)));
typedef float f32x4 __attribute__((ext_vector_type(4)));
typedef unsigned u32x4 __attribute__((ext_vector_type(4)));
constexpr int BM = 256, BK = 64, HALF = 128, HTB = HALF * BK * 2  , STAGE_BYTES = 8 * HTB, NXCD = 8, WGM = 8;

__host__ __device__ __forceinline__ int lds_byte(int r, int c) { const int st = (r >> 4) * 2 + (c >> 5), rr = r & 15, cc = c & 31, ob = rr * 64 + cc * 2; return st * 1024 + (ob ^ (((ob >> 9) & 1) << 5)); }
__host__ __device__ __forceinline__ void stage_rc(int b, int& R, int& C) { const int st = b / 1024, sb = b % 1024, swz = sb ^ (((sb >> 9) & 1) << 5); R = (st >> 1) * 16 + swz / 64; C = (st & 1) * 32 + (swz % 64) / 2; }
__host__ __device__ __forceinline__ int perm32(int rho) { const int n = rho >> 4, i = rho & 15; return 8 * (i >> 2) + 4 * n + (i & 3); }

struct Unit { int pm, pn; };
struct Gemm { const bf16_t* A; const bf16_t* Bt; int M, N, K; };

struct StaticOrder {
    int nM, nN, nwg, G, c;
    __host__ __device__ void init(int M, int N, int G_, int c_) { nM = M / BM; nN = N / BM; nwg = nM * nN; G = G_; c = c_; }
    __host__ __device__ bool next(int i, Unit& u) const {
        const long L = (long)i * G + c; if (L >= nwg) return false;
        int wgid = (int)L; { const int q = nwg / NXCD, r = nwg % NXCD, xcd = wgid % NXCD, off = wgid / NXCD; wgid = (xcd < r ? xcd * (q + 1) : r * (q + 1) + (xcd - r) * q) + off; }
        const int nig = WGM * nN, gid = wgid / nig, fm = gid * WGM, gsz = (nM - fm) < WGM ? (nM - fm) : WGM;
        u.pm = fm + ((wgid % nig) % gsz); u.pn = (wgid % nig) / gsz; return true;
    }
    __device__ __forceinline__ void a_ready(const Unit&, int) const {}
    __device__ __forceinline__ void done(const Unit&) const {}
};


typedef __bf16 bfx2_t __attribute__((ext_vector_type(2)));
__device__ __forceinline__ unsigned pk2(float lo, float hi) { bfx2_t v; v.x = (__bf16)lo; v.y = (__bf16)hi; return __builtin_bit_cast(unsigned, v); }
__device__ __forceinline__ u32x4 pk8(const f32x4 a, const f32x4 b) { u32x4 w; w.x = pk2(a[0], a[1]); w.y = pk2(a[2], a[3]); w.z = pk2(b[0], b[1]); w.w = pk2(b[2], b[3]); return w; }
__device__ __forceinline__ float rowscale(const float* SS, int row) {
    const f32x4* p = (const f32x4*)(SS + (size_t)row * 16);
    const f32x4 a = p[0], b = p[1], c = p[2], d = p[3];
    const float s = ((a[0] + a[1]) + (a[2] + a[3])) + ((b[0] + b[1]) + (b[2] + b[3])) + ((c[0] + c[1]) + (c[2] + c[3])) + ((d[0] + d[1]) + (d[2] + d[3]));
    return 1.0f / sqrtf(s * (1.0f / 1024.0f) + 1e-6f);
}
__device__ __forceinline__ float sigmoid_f(float x) { return __builtin_amdgcn_rcpf(1.0f + __builtin_amdgcn_exp2f(-1.4426950408889634f * x)); }
__device__ __forceinline__ f32x4 silu4(const f32x4 g) { f32x4 o; o[0] = g[0] * sigmoid_f(g[0]); o[1] = g[1] * sigmoid_f(g[1]); o[2] = g[2] * sigmoid_f(g[2]); o[3] = g[3] * sigmoid_f(g[3]); return o; }
__device__ __forceinline__ f32x4 sig4(const f32x4 g) { f32x4 o; o[0] = sigmoid_f(g[0]); o[1] = sigmoid_f(g[1]); o[2] = sigmoid_f(g[2]); o[3] = sigmoid_f(g[3]); return o; }

struct EpiSwiGLU {
    static constexpr bool PERM = true, AFTER_DRAIN = false;
    bf16_t* H; const PG8_LAS float* rs; int ldh;
    __device__ __forceinline__ void operator()(const f32x4 (&acc)[2][2][4][2], const Unit& u, int wr, int wc, int fr, int fq, int ui) const {
        const int row0 = u.pm * BM + wr * 64 + fr, col0 = u.pn * HALF + wc * 32 + 8 * fq;
#pragma unroll
        for (int ai = 0; ai < 2; ++ai)
#pragma unroll
            for (int m = 0; m < 4; ++m) {
                const int row = row0 + ai * HALF + m * 16; const float r = rs[ui * 256 + ai * HALF + wr * 64 + m * 16 + fr];
                const f32x4 g0 = acc[ai][0][m][0] * r, g1 = acc[ai][0][m][1] * r, u0 = acc[ai][1][m][0] * r, u1 = acc[ai][1][m][1] * r;
                *(u32x4*)(H + (size_t)row * ldh + col0) = pk8(silu4(g0) * u0, silu4(g1) * u1);
            }
    }
};

struct EpiResid {
    static constexpr bool PERM = true, AFTER_DRAIN = false;
    bf16_t* xb; float* SSout; float scale;
    __device__ __forceinline__ void operator()(const f32x4 (&acc)[2][2][4][2], const Unit& u, int wr, int wc, int fr, int fq, int ui) const {
        const int row0 = u.pm * BM + wr * 64 + fr, col0 = u.pn * BM + wc * 32 + 8 * fq;
        u32x4 old[2][4][2];
#pragma unroll
        for (int ai = 0; ai < 2; ++ai)
#pragma unroll
            for (int m = 0; m < 4; ++m)
#pragma unroll
                for (int bj = 0; bj < 2; ++bj) old[ai][m][bj] = *(const u32x4*)(xb + (size_t)(row0 + ai * HALF + m * 16) * 1024 + col0 + bj * HALF);
#pragma unroll
        for (int ai = 0; ai < 2; ++ai)
#pragma unroll
            for (int m = 0; m < 4; ++m) {
                const int row = row0 + ai * HALF + m * 16; float ss = 0.f;
#pragma unroll
                for (int bj = 0; bj < 2; ++bj) {
                    const u32x4 w = old[ai][m][bj];
                    const f32x4 b0 = {__uint_as_float(w.x << 16), __uint_as_float(w.x & 0xffff0000u), __uint_as_float(w.y << 16), __uint_as_float(w.y & 0xffff0000u)};
                    const f32x4 b1 = {__uint_as_float(w.z << 16), __uint_as_float(w.z & 0xffff0000u), __uint_as_float(w.w << 16), __uint_as_float(w.w & 0xffff0000u)};
                    const f32x4 o0 = b0 + acc[ai][bj][m][0] * scale, o1 = b1 + acc[ai][bj][m][1] * scale;
                    *(u32x4*)(xb + (size_t)row * 1024 + col0 + bj * HALF) = pk8(o0, o1);
                    ss += ((o0[0] * o0[0] + o0[1] * o0[1]) + (o0[2] * o0[2] + o0[3] * o0[3])) + ((o1[0] * o1[0] + o1[1] * o1[1]) + (o1[2] * o1[2] + o1[3] * o1[3]));
                }
                ss += __shfl_xor(ss, 16); ss += __shfl_xor(ss, 32);
                if (fq == 0) SSout[(size_t)row * 16 + u.pn * 4 + wc] = ss;
            }
    }
};

struct EpiMixN {
    static constexpr bool PERM = true, AFTER_DRAIN = false;
    bf16_t* P; const PG8_LAS float* rs; const float* cosT; const float* sinT; int ldp;
    __device__ __forceinline__ void operator()(const f32x4 (&acc)[2][2][4][2], const Unit& u, int wr, int wc, int fr, int fq, int ui) const {
        const int row0 = u.pm * BM + wr * 64 + fr, pn = u.pn;
#pragma unroll
        for (int ai = 0; ai < 2; ++ai)
#pragma unroll
            for (int m = 0; m < 4; ++m) {
                const int row = row0 + ai * HALF + m * 16; const float r = rs[ui * 256 + ai * HALF + wr * 64 + m * 16 + fr];
                const f32x4 a0 = acc[ai][0][m][0] * r, a1 = acc[ai][0][m][1] * r, b0 = acc[ai][1][m][0] * r, b1 = acc[ai][1][m][1] * r;
                bf16_t* prow = P + (size_t)row * ldp;
                if (pn < 2) {
                    *(u32x4*)(prow + pn * HALF + wc * 32 + 8 * fq) = pk8(a0 * sig4(b0), a1 * sig4(b1));
                } else if (pn == 6 || pn == 7) {
                    const int pos = row & 8191; const size_t to = (size_t)pos * 32 + 8 * fq;
                    const f32x4 c0 = *(const f32x4*)(cosT + to), c1 = *(const f32x4*)(cosT + to + 4), s0 = *(const f32x4*)(sinT + to), s1 = *(const f32x4*)(sinT + to + 4);
                    const float sc = (pn == 6) ? 0.125f : 1.0f;
                    const f32x4 x0 = (a0 * c0 - b0 * s0) * sc, x1 = (a1 * c1 - b1 * s1) * sc, y0 = (a0 * s0 + b0 * c0) * sc, y1 = (a1 * s1 + b1 * c1) * sc;
                    bf16_t* q = prow + (pn == 6 ? 1280 : 1536) + wc * 64 + 8 * fq;
                    *(u32x4*)(q) = pk8(x0, x1); *(u32x4*)(q + 32) = pk8(y0, y1);
                } else {
                    bf16_t* q = prow + (pn == 8 ? 1792 : 256 + (pn - 2) * 256) + wc * 32 + 8 * fq;
                    *(u32x4*)(q) = pk8(a0, a1); *(u32x4*)(q + HALF) = pk8(b0, b1);
                }
            }
    }
};

struct EpiMixT {
    static constexpr bool PERM = true, AFTER_DRAIN = false;
    bf16_t* T; const PG8_LAS float* rs; const float* cosTT; const float* sinTT; int ldt;
    __device__ __forceinline__ void operator()(const f32x4 (&acc)[2][2][4][2], const Unit& u, int wr, int wc, int fr, int fq, int ui) const {
        const int pm = u.pm;
#pragma unroll
        for (int bj = 0; bj < 2; ++bj) {
            const int tok0 = u.pn * BM + bj * HALF + wc * 32 + 8 * fq;
            const PG8_LAS f32x4* rp = (const PG8_LAS f32x4*)(rs + ui * 256 + bj * HALF + wc * 32 + 8 * fq);
            const f32x4 r0 = rp[0], r1 = rp[1];
            if (pm < 3) {
#pragma unroll
                for (int ai = 0; ai < 2; ++ai)
#pragma unroll
                    for (int m = 0; m < 4; ++m) {
                        const int f = pm * BM + ai * HALF + wr * 64 + m * 16 + fr;
                        *(u32x4*)(T + (size_t)f * ldt + tok0) = pk8(acc[ai][bj][m][0] * r0, acc[ai][bj][m][1] * r1);
                    }
            } else {
                const int pos0 = tok0 & 8191, tk = tok0 & 63;
#pragma unroll
                for (int m = 0; m < 4; ++m) {
                    const int x = wr * 64 + m * 16 + fr, hh = x >> 5, dd = x & 31;
                    const float lg = (hh == 0) ? -0.04580368961312479f : (hh == 1) ? -0.02272007650008353f : (hh == 2) ? -0.011315313227834146f : -0.005646563141142063f;
                    f32x4 k0, k1;
#pragma unroll
                    for (int e = 0; e < 4; ++e) { k0[e] = __builtin_amdgcn_exp2f(lg * (float)(63 - tk - e)); k1[e] = __builtin_amdgcn_exp2f(lg * (float)(59 - tk - e)); }
                    const size_t to = (size_t)dd * 8192 + pos0;
                    const f32x4 c0 = *(const f32x4*)(cosTT + to), c1 = *(const f32x4*)(cosTT + to + 4), s0 = *(const f32x4*)(sinTT + to), s1 = *(const f32x4*)(sinTT + to + 4);
                    const f32x4 a0 = acc[0][bj][m][0] * r0, a1 = acc[0][bj][m][1] * r1, b0 = acc[1][bj][m][0] * r0, b1 = acc[1][bj][m][1] * r1;
                    const f32x4 x0 = (a0 * c0 - b0 * s0) * k0, x1 = (a1 * c1 - b1 * s1) * k1, y0 = (a0 * s0 + b0 * c0) * k0, y1 = (a1 * s1 + b1 * c1) * k1;
                    bf16_t* q = T + (size_t)(768 + hh * 64 + dd) * ldt + tok0;
                    *(u32x4*)(q) = pk8(x0, x1); *(u32x4*)(q + (size_t)32 * ldt) = pk8(y0, y1);
                }
            }
        }
    }
};

template <class Epi, class Sched, bool ALIGN_EPI = false, bool SP2 = false>
__device__ __forceinline__ void gemm_phase(PG8_LAS unsigned char* lds, const Gemm g, const Sched& S, const Epi& E) {
    const int tid = threadIdx.x, wid = __builtin_amdgcn_readfirstlane(tid >> 6), lane = tid & 63, wr = wid >> 2, wc = wid & 3, fr = lane & 15, fq = lane >> 4;
    const int K = g.K, nt = K / BK;
    unsigned voffA[2], voffB[2];
#pragma unroll
    for (int i = 0; i < 2; ++i) { int R, C; stage_rc(tid * 16 + i * 8192, R, C); const int Rb = Epi::PERM ? ((R & ~31) + perm32(R & 31)) : R;
        voffA[i] = (unsigned)(R * K + C) * 2u; voffB[i] = (unsigned)(Rb * K + C) * 2u; }
    const size_t kstep = (size_t)(BK * 2);
    const size_t hstep = (size_t)HALF * K * 2;
    const size_t tstep = 2 * hstep;
    const unsigned ldsw = (unsigned)wid * 1024u;
    const int aoff = lds_byte(wr * 64 + fr, fq * 8), boff = lds_byte(wc * 32 + fr, fq * 8);
#define PG8_SA(b, h) (((b) * 2 + (h)) * HTB)
#define PG8_SB(b, h) ((4 + (b) * 2 + (h)) * HTB)
#define PG8_STAGE(bufoff, gbase, voff) do { _Pragma("unroll") for (int _i = 0; _i < 2; ++_i) \
        __builtin_amdgcn_global_load_lds((const unsigned*)((const char*)(gbase) + (voff)[_i]), (PG8_LAS unsigned*)(lds + (bufoff) + ldsw + _i * 8192), 16, 0, 0); } while (0)
#define PG8_LDA(dst, b, h) do { _Pragma("unroll") for (int m = 0; m < 4; ++m) _Pragma("unroll") for (int k = 0; k < 2; ++k) dst[m][k] = *(const PG8_LAS bf16x8*)(lds + PG8_SA(b, h) + aoff + m * 2048 + k * 1024); } while (0)
#define PG8_LDB(dst, b, h) do { _Pragma("unroll") for (int n = 0; n < 2; ++n) _Pragma("unroll") for (int k = 0; k < 2; ++k) dst[n][k] = *(const PG8_LAS bf16x8*)(lds + PG8_SB(b, h) + boff + n * 2048 + k * 1024); } while (0)
#define PG8_MMA(ai, bj, At, Bt) do { __builtin_amdgcn_s_setprio(1); _Pragma("unroll") for (int m = 0; m < 4; ++m) _Pragma("unroll") for (int n = 0; n < 2; ++n) _Pragma("unroll") for (int k = 0; k < 2; ++k) \
        acc[ai][bj][m][n] = __builtin_amdgcn_mfma_f32_16x16x32_bf16(Bt[n][k], At[m][k], acc[ai][bj][m][n], 0, 0, 0); __builtin_amdgcn_s_setprio(0); } while (0)
#define PG8_WAIT_V(n) asm volatile("s_waitcnt vmcnt(" #n ")" ::: "memory")
#define PG8_WAIT_L(n) asm volatile("s_waitcnt lgkmcnt(" #n ")" ::: "memory")
#define PG8_BAR __builtin_amdgcn_s_barrier()
#define PG8_SCHED __builtin_amdgcn_sched_barrier(0)
    Unit cur, nxt; int ui = 0;
    if (!S.next(0, cur)) return;
    f32x4 acc[2][2][4][2];
#pragma unroll
    for (int a = 0; a < 2; ++a)
#pragma unroll
        for (int b = 0; b < 2; ++b)
#pragma unroll
            for (int m = 0; m < 4; ++m)
#pragma unroll
                for (int n = 0; n < 2; ++n) acc[a][b][m][n] = (f32x4){0.f, 0.f, 0.f, 0.f};
    bf16x8 At[4][2], B0[2][2], B1[2][2];
    const char* cA = (const char*)g.A + (size_t)cur.pm * tstep; const char* cB = (const char*)g.Bt + (size_t)cur.pn * tstep;
    S.a_ready(cur, 0);
    if constexpr (SP2) {
        PG8_STAGE(PG8_SB(0, 0), cB, voffB); PG8_STAGE(PG8_SB(0, 1), cB + hstep, voffB); PG8_STAGE(PG8_SA(0, 0), cA, voffA); PG8_STAGE(PG8_SA(0, 1), cA + hstep, voffA);
        if (wr == 1) PG8_BAR;
        PG8_WAIT_V(2); PG8_BAR;
        PG8_STAGE(PG8_SB(1, 0), cB + kstep, voffB); PG8_STAGE(PG8_SA(1, 0), cA + kstep, voffA); PG8_STAGE(PG8_SB(1, 1), cB + hstep + kstep, voffB);
        PG8_WAIT_V(6); PG8_BAR;
    } else {
        PG8_STAGE(PG8_SB(0, 0), cB, voffB); PG8_STAGE(PG8_SA(0, 0), cA, voffA); PG8_STAGE(PG8_SB(0, 1), cB + hstep, voffB); PG8_STAGE(PG8_SA(0, 1), cA + hstep, voffA);
        if (wr == 1) PG8_BAR;
        PG8_WAIT_V(4); PG8_BAR;
        PG8_STAGE(PG8_SB(1, 0), cB + kstep, voffB); PG8_STAGE(PG8_SA(1, 0), cA + kstep, voffA); PG8_STAGE(PG8_SB(1, 1), cB + hstep + kstep, voffB);
        PG8_WAIT_V(6); PG8_BAR;
    }
    for (;;) {
        const bool has_next = S.next(ui + 1, nxt);
        const char* nA = has_next ? (const char*)g.A + (size_t)nxt.pm * tstep : cA; const char* nB = has_next ? (const char*)g.Bt + (size_t)nxt.pn * tstep : cB;
        for (int t = 0; t < nt; t += 2) {
            const bool last = (t == nt - 2);
            const char* a1 = cA + (size_t)(t + 1) * kstep;
            const char* a2 = last ? nA : cA + (size_t)(t + 2) * kstep; const char* b2 = last ? nB : cB + (size_t)(t + 2) * kstep;
            const char* a3 = a2 + kstep; const char* b3 = b2 + kstep;
            if (last && has_next) S.a_ready(nxt, ui + 1);
            if constexpr (SP2) {
            PG8_LDB(B0, 0, 0); PG8_LDB(B1, 0, 1); PG8_SCHED; PG8_LDA(At, 0, 0); PG8_STAGE(PG8_SA(1, 1), a1 + hstep, voffA);
            PG8_WAIT_V(8); PG8_WAIT_L(0); PG8_BAR; PG8_MMA(0, 0, At, B0); PG8_MMA(0, 1, At, B1); PG8_BAR; PG8_SCHED;
            PG8_LDA(At, 0, 1); PG8_STAGE(PG8_SB(0, 0), b2, voffB); PG8_STAGE(PG8_SB(0, 1), b2 + hstep, voffB); PG8_STAGE(PG8_SA(0, 0), a2, voffA);
            PG8_WAIT_V(8); PG8_WAIT_L(0); PG8_BAR; PG8_MMA(1, 0, At, B0); PG8_MMA(1, 1, At, B1); PG8_BAR; PG8_SCHED;
            PG8_LDB(B0, 1, 0); PG8_LDB(B1, 1, 1); PG8_SCHED; PG8_LDA(At, 1, 0); PG8_STAGE(PG8_SA(0, 1), a2 + hstep, voffA);
            PG8_WAIT_V(8); PG8_WAIT_L(0); PG8_BAR; PG8_MMA(0, 0, At, B0); PG8_MMA(0, 1, At, B1); PG8_BAR; PG8_SCHED;
            PG8_LDA(At, 1, 1); PG8_STAGE(PG8_SB(1, 0), b3, voffB); PG8_STAGE(PG8_SB(1, 1), b3 + hstep, voffB); PG8_STAGE(PG8_SA(1, 0), a3, voffA);
            PG8_WAIT_V(8); PG8_WAIT_L(0); PG8_BAR; PG8_MMA(1, 0, At, B0); PG8_MMA(1, 1, At, B1); PG8_BAR; PG8_SCHED;
            } else {
            PG8_LDB(B0, 0, 0); PG8_SCHED; PG8_LDA(At, 0, 0); PG8_STAGE(PG8_SA(1, 1), a1 + hstep, voffA);
            PG8_WAIT_L(8); PG8_BAR; PG8_WAIT_L(0); PG8_MMA(0, 0, At, B0); PG8_BAR; PG8_SCHED;
            PG8_LDB(B1, 0, 1); PG8_STAGE(PG8_SB(0, 0), b2, voffB);
            PG8_BAR; PG8_WAIT_L(0); PG8_MMA(0, 1, At, B1); PG8_BAR;
            PG8_LDA(At, 0, 1); PG8_STAGE(PG8_SA(0, 0), a2, voffA);
            PG8_BAR; PG8_WAIT_L(0); PG8_MMA(1, 0, At, B0); PG8_BAR; PG8_SCHED;
            PG8_STAGE(PG8_SB(0, 1), b2 + hstep, voffB);
            PG8_WAIT_V(6); PG8_BAR; PG8_MMA(1, 1, At, B1); PG8_BAR;
            PG8_LDB(B0, 1, 0); PG8_SCHED; PG8_LDA(At, 1, 0); PG8_STAGE(PG8_SA(0, 1), a2 + hstep, voffA);
            PG8_WAIT_L(8); PG8_BAR; PG8_WAIT_L(0); PG8_MMA(0, 0, At, B0); PG8_BAR; PG8_SCHED;
            PG8_LDB(B1, 1, 1); PG8_STAGE(PG8_SB(1, 0), b3, voffB);
            PG8_BAR; PG8_WAIT_L(0); PG8_MMA(0, 1, At, B1); PG8_BAR;
            PG8_LDA(At, 1, 1); PG8_STAGE(PG8_SA(1, 0), a3, voffA);
            PG8_BAR; PG8_WAIT_L(0); PG8_MMA(1, 0, At, B0); PG8_BAR; PG8_SCHED;
            PG8_STAGE(PG8_SB(1, 1), b3 + hstep, voffB);
            PG8_WAIT_V(6); PG8_BAR; PG8_MMA(1, 1, At, B1); PG8_BAR;
            }
        }
        if constexpr (ALIGN_EPI) { if (wr == 0) PG8_BAR; }
        if constexpr (!Epi::AFTER_DRAIN) { E(acc, cur, wr, wc, fr, fq, ui); S.done(cur); }
        if (!has_next) break;
#pragma unroll
        for (int a = 0; a < 2; ++a)
#pragma unroll
            for (int b = 0; b < 2; ++b)
#pragma unroll
                for (int m = 0; m < 4; ++m)
#pragma unroll
                    for (int n = 0; n < 2; ++n) acc[a][b][m][n] = (f32x4){0.f, 0.f, 0.f, 0.f};
        cur = nxt; cA = nA; cB = nB; ++ui;
        if constexpr (ALIGN_EPI) { if (wr == 1) PG8_BAR; }
    }
    PG8_WAIT_V(0);
    if constexpr (!ALIGN_EPI) { if (wr == 0) PG8_BAR; }
    PG8_BAR;
    if constexpr (Epi::AFTER_DRAIN) { E.fused(acc, cur, wr, wc, fr, fq, lds, wid, lane); S.done(cur); }
#undef PG8_SA
#undef PG8_SB
#undef PG8_STAGE
#undef PG8_LDA
#undef PG8_LDB
#undef PG8_MMA
#undef PG8_WAIT_V
#undef PG8_WAIT_L
#undef PG8_BAR
#undef PG8_SCHED
}
}

constexpr int BATCH = 4, SEQ = 8192, DM = 1024, DEPTH = 2, M_TOK = BATCH * SEQ;
constexpr int FF = 2816, NFF = 2 * FF, NMIX = 3072;
constexpr int PW = 2048 + 64;
constexpr int LDT = M_TOK + 64;
constexpr int P_CV = 0, P_QSB = 256, P_KSB = 768, P_QR = 1280, P_KR = 1536, P_GR = 1792;
constexpr int T_VSB = 0, T_VR = 512, T_KR = 768;
constexpr int Y_CV = 0, Y_SB = 256, Y_R = 768;
constexpr int GC = 4, NG = (SEQ / 64) / GC;
constexpr int NWAVES = 8, NTHR = NWAVES * 64;
constexpr int SB_PART1 = 0;
constexpr int LDS_BYTES = 147456;

constexpr size_t MiB = 1u << 20;
constexpr size_t WS_CTL = 0, CTL_BYTES = 65536;
constexpr size_t WS_W = 1 * MiB, W_STRIDE = 42 * MiB;
constexpr size_t WO_1I = 0, WO_1O = 11 * MiB, WO_MN = 33 * MiB / 2, WO_MT = 21 * MiB, WO_MO = 23 * MiB, WO_2I = 25 * MiB, WO_2O = 36 * MiB;
constexpr size_t WS_ROT = 85 * MiB;
constexpr size_t WS_SS = 89 * MiB;
constexpr size_t WS_G = 91 * MiB;
constexpr size_t WS_XB = 100 * MiB, WS_Y = 164 * MiB, WS_T = 228 * MiB, WS_H = 293 * MiB, WS_SP = 469 * MiB, WS_END = 477 * MiB;

#define LAS __attribute__((address_space(3)))
#define DI __device__ __forceinline__
typedef unsigned short bf16_t;
typedef __bf16 bfx8 __attribute__((ext_vector_type(8)));
typedef float f32x16 __attribute__((ext_vector_type(16)));
typedef float f32x4 __attribute__((ext_vector_type(4)));
typedef unsigned u32x4 __attribute__((ext_vector_type(4)));
typedef unsigned u32x2 __attribute__((ext_vector_type(2)));
#define MFMA32(a, b, c) __builtin_amdgcn_mfma_f32_32x32x16_bf16((a), (b), (c), 0, 0, 0)
#define EXP2(x) __builtin_amdgcn_exp2f(x)
#define LOG2(x) __builtin_amdgcn_logf(x)
using pg8::pk2;

DI int crow(int reg, int h) { return (reg & 3) + 8 * (reg >> 2) + 4 * h; }
DI f32x16 zero16() { f32x16 z;
#pragma unroll
    for (int i = 0; i < 16; ++i) z[i] = 0.f; return z; }
template <int S> DI bfx8 pack8(const f32x16& x) {
    u32x4 p; p.x = pk2(x[8 * S], x[8 * S + 1]); p.y = pk2(x[8 * S + 2], x[8 * S + 3]); p.z = pk2(x[8 * S + 4], x[8 * S + 5]); p.w = pk2(x[8 * S + 6], x[8 * S + 7]);
    return __builtin_bit_cast(bfx8, p);
}
DI bfx8 ld8(const bf16_t* p) { return *(const bfx8*)p; }
DI bfx8 ld44(const bf16_t* p) { u32x4 v; const u32x2 a = *(const u32x2*)p, b = *(const u32x2*)(p + 8); v.x = a.x; v.y = a.y; v.z = b.x; v.w = b.y; return __builtin_bit_cast(bfx8, v); }
DI bfx8 lds44(const LAS unsigned char* img, int row, int x, int hi) { const int sw = (row >> 1) & 7; u32x4 v; const u32x2 a = *(const LAS u32x2*)(img + row * 128 + (((2 * x) ^ sw) << 4) + 8 * hi), b = *(const LAS u32x2*)(img + row * 128 + (((2 * x + 1) ^ sw) << 4) + 8 * hi); v.x = a.x; v.y = a.y; v.z = b.x; v.w = b.y; return __builtin_bit_cast(bfx8, v); }
DI float bf_lo(unsigned u) { return __uint_as_float(u << 16); }
DI float bf_hi(unsigned u) { return __uint_as_float(u & 0xffff0000u); }
DI float wave_sum(float v) {
#pragma unroll
    for (int o = 1; o < 64; o <<= 1) v += __shfl_xor(v, o);
    return v;
}
DI float lgamma2(int h) { return (h == 0) ? -0.04580368961312479f : (h == 1) ? -0.02272007650008353f : (h == 2) ? -0.011315313227834146f : -0.005646563141142063f; }

#define SB_TILE(QF, O0, O1, RR, TQ) do { \
        f32x16 s0 = zero16(), s1 = zero16(); \
        _Pragma("unroll") for (int kk = 0; kk < 4; ++kk) { \
            const bfx8 k0 = *(const LAS bfx8*)(kl0 + (((2 * kk + hi) ^ ksw) << 4)), k1 = *(const LAS bfx8*)(kl0 + 4096 + (((2 * kk + hi) ^ ksw) << 4)); \
            s0 = MFMA32(k0, QF[kk], s0); s1 = MFMA32(k1, QF[kk], s1); } \
        bfx8 v00, v01, v02, v03, v10, v11, v12, v13;          \
        { v00 = *(const LAS bfx8*)(vl0 + (((2 * hi) ^ vsw) << 4)); v01 = *(const LAS bfx8*)(vl0 + (((2 * hi + 1) ^ vsw) << 4)); v02 = *(const LAS bfx8*)(vl0 + (((4 + 2 * hi) ^ vsw) << 4)); v03 = *(const LAS bfx8*)(vl0 + (((5 + 2 * hi) ^ vsw) << 4)); \
          v10 = *(const LAS bfx8*)(vl0 + 4096 + (((2 * hi) ^ vsw) << 4)); v11 = *(const LAS bfx8*)(vl0 + 4096 + (((2 * hi + 1) ^ vsw) << 4)); v12 = *(const LAS bfx8*)(vl0 + 4096 + (((4 + 2 * hi) ^ vsw) << 4)); v13 = *(const LAS bfx8*)(vl0 + 4096 + (((5 + 2 * hi) ^ vsw) << 4)); } \
          \
        _Pragma("unroll") for (int i = 0; i < 16; ++i) { \
            { float om = __builtin_amdgcn_rcpf(1.0f + EXP2(fminf(s0[i] * ZC, 64.0f))); \
              if (diag) om = ((key0 + i) < (TQ)) ? om : 1.0f; \
              s0[i] = om; } \
            { float om = __builtin_amdgcn_rcpf(1.0f + EXP2(fminf(s1[i] * ZC, 64.0f))); \
              if (diag) om = ((key0 + 32 + i) < (TQ)) ? om : 1.0f; \
              s1[i] = om; } } \
        const float m0 = (((s0[0] * s0[1]) * (s0[2] * s0[3])) * ((s0[4] * s0[5]) * (s0[6] * s0[7]))) * (((s0[8] * s0[9]) * (s0[10] * s0[11])) * ((s0[12] * s0[13]) * (s0[14] * s0[15]))); \
        const float m1 = (((s1[0] * s1[1]) * (s1[2] * s1[3])) * ((s1[4] * s1[5]) * (s1[6] * s1[7]))) * (((s1[8] * s1[9]) * (s1[10] * s1[11])) * ((s1[12] * s1[13]) * (s1[14] * s1[15]))); \
        const float x0 = __shfl_xor(m0, 32), x1 = __shfl_xor(m1, 32);     \
        const float c1 = (hi == 0) ? RR * x1 : RR;            \
        const float base = RR * (m1 * x1); \
        const float c0 = (hi == 0) ? base * x0 : base; \
        RR = base * (m0 * x0); \
        { float t = c1; _Pragma("unroll") for (int i = 15; i >= 0; --i) { const float l = s1[i]; s1[i] = __builtin_fmaf(-l, t, t); t *= l; } } \
        { float t = c0; _Pragma("unroll") for (int i = 15; i >= 0; --i) { const float l = s0[i]; s0[i] = __builtin_fmaf(-l, t, t); t *= l; } } \
        { const bfx8 w = pack8<0>(s0); O0 = MFMA32(v00, w, O0); O1 = MFMA32(v10, w, O1); } \
        { const bfx8 w = pack8<1>(s0); O0 = MFMA32(v01, w, O0); O1 = MFMA32(v11, w, O1); } \
        { const bfx8 w = pack8<0>(s1); O0 = MFMA32(v02, w, O0); O1 = MFMA32(v12, w, O1); } \
        { const bfx8 w = pack8<1>(s1); O0 = MFMA32(v03, w, O0); O1 = MFMA32(v13, w, O1); } } while (0)

DI void sb_unit(int item, const bf16_t* __restrict__ P, const bf16_t* __restrict__ T, bf16_t* __restrict__ Y, int lane, LAS unsigned char* wl) {
    const int qp2 = item & 127, bh = item >> 7, b = bh >> 3, h = bh & 7;
    const int n = lane & 31, hi = lane >> 5;
    const int t0 = qp2 * 64, tqa = t0 + n, tqb = t0 + 32 + n;
    const size_t tokb = (size_t)b * SEQ;
    bfx8 qa[4], qb[4];
    {
        const int srow_ = lane >> 3, sch_ = lane & 7;
        const bf16_t* qg = P + (tokb + t0 + srow_) * PW + P_QSB + h * 64 + 8 * sch_;
        u32x4 qr[8];
#pragma unroll
        for (int i = 0; i < 8; ++i) qr[i] = *(const u32x4*)(qg + (size_t)(8 * i) * PW);
#pragma unroll
        for (int i = 0; i < 8; ++i) { const int r = 8 * i + srow_; *(LAS u32x4*)(wl + r * 128 + ((sch_ ^ ((r >> 1) & 7)) << 4)) = qr[i]; }
#pragma unroll
        for (int kk = 0; kk < 4; ++kk) { qa[kk] = *(const LAS bfx8*)(wl + n * 128 + (((2 * kk + hi) ^ ((n >> 1) & 7)) << 4)); qb[kk] = *(const LAS bfx8*)(wl + (32 + n) * 128 + (((2 * kk + hi) ^ ((n >> 1) & 7)) << 4)); }
    }
    f32x16 oa0 = zero16(), oa1 = zero16(), ob0 = zero16(), ob1 = zero16(); float Ra = 1.0f, Rb = 1.0f;
    const int kmap = 16 * ((n >> 2) & 1) + 4 * (n >> 3) + (n & 3);
    const int srow = lane >> 3, sch = lane & 7;
    const bf16_t* kg = P + (tokb + srow) * PW + P_KSB + h * 64 + 8 * sch;
    const bf16_t* vg = T + (size_t)(T_VSB + h * 64 + srow) * LDT + tokb + 8 * sch;
    const LAS unsigned char* kl0 = wl + kmap * 128; const int ksw = (kmap >> 1) & 7;
    const LAS unsigned char* vl0 = wl + 8192 + n * 128; const int vsw = (n >> 1) & 7;
    const int kd = t0 >> 6;
    const float ZC = 0.18033688011112042f;
    bool livea = true, liveb = true;
    for (int kt = kd; kt >= 0; --kt) {
        const int kbase = kt * 64;
        { u32x4 kr[8], vr[8];
#pragma unroll
          for (int i = 0; i < 8; ++i) { kr[i] = *(const u32x4*)(kg + (size_t)(kbase + 8 * i) * PW); vr[i] = *(const u32x4*)(vg + (size_t)(8 * i) * LDT + kbase); }
#pragma unroll
          for (int i = 0; i < 8; ++i) { const int r = 8 * i + srow; const int off = r * 128 + ((sch ^ ((r >> 1) & 7)) << 4);
              *(LAS u32x4*)(wl + off) = kr[i]; *(LAS u32x4*)(wl + 8192 + off) = vr[i]; } }
        const bool diag = (kt == kd);
        const int key0 = kbase + 16 * hi;
        if (livea) { SB_TILE(qa, oa0, oa1, Ra, tqa); livea = __builtin_amdgcn_ballot_w64(Ra > 1e-36f) != 0ull; }
        if (liveb) { SB_TILE(qb, ob0, ob1, Rb, tqb); liveb = __builtin_amdgcn_ballot_w64(Rb > 1e-36f) != 0ull; }
        if (!livea && !liveb) break;
    }
    {
#pragma unroll
        for (int g = 0; g < 4; ++g) {
            const int ra = n, rb = 32 + n;
            u32x2 w; w.x = pk2(oa0[4 * g], oa0[4 * g + 1]); w.y = pk2(oa0[4 * g + 2], oa0[4 * g + 3]); *(LAS u32x2*)(wl + ra * 128 + (((g) ^ ((ra >> 1) & 7)) << 4) + 8 * hi) = w;
            u32x2 w2; w2.x = pk2(oa1[4 * g], oa1[4 * g + 1]); w2.y = pk2(oa1[4 * g + 2], oa1[4 * g + 3]); *(LAS u32x2*)(wl + ra * 128 + (((4 + g) ^ ((ra >> 1) & 7)) << 4) + 8 * hi) = w2;
            u32x2 w3; w3.x = pk2(ob0[4 * g], ob0[4 * g + 1]); w3.y = pk2(ob0[4 * g + 2], ob0[4 * g + 3]); *(LAS u32x2*)(wl + rb * 128 + (((g) ^ ((rb >> 1) & 7)) << 4) + 8 * hi) = w3;
            u32x2 w4; w4.x = pk2(ob1[4 * g], ob1[4 * g + 1]); w4.y = pk2(ob1[4 * g + 2], ob1[4 * g + 3]); *(LAS u32x2*)(wl + rb * 128 + (((4 + g) ^ ((rb >> 1) & 7)) << 4) + 8 * hi) = w4;
        }
        bf16_t* yg = Y + (tokb + t0 + srow) * DM + Y_SB + h * 64 + 8 * sch;
#pragma unroll
        for (int i = 0; i < 8; ++i) { const int r = 8 * i + srow; *(u32x4*)(yg + (size_t)(8 * i) * DM) = *(const LAS u32x4*)(wl + r * 128 + ((sch ^ ((r >> 1) & 7)) << 4)); }
    }
}

DI void conv_unit(int item, const bf16_t* __restrict__ P, bf16_t* __restrict__ Y, const float* __restrict__ cw, const float* __restrict__ cb,
                  const float* __restrict__ lng, const float* __restrict__ lnb, int lane) {
    const int tok0 = item * 16;
    f32x4 w[31];
#pragma unroll
    for (int j = 0; j < 31; ++j) w[j] = *(const f32x4*)(cw + j * 256 + 4 * lane);
    const f32x4 bias = *(const f32x4*)(cb + 4 * lane), g4 = *(const f32x4*)(lng + 4 * lane), b4 = *(const f32x4*)(lnb + 4 * lane);
#pragma unroll 1
    for (int ps = 0; ps < 4; ++ps) {
        const int tok = tok0 + 4 * ps, tl = tok & (SEQ - 1);
        const bf16_t* src = P + (size_t)tok * PW + P_CV + 4 * lane;
        u32x2 r[34];
#pragma unroll
        for (int i = 0; i < 34; ++i) { const bool ok = (tl - 30 + i) >= 0; const u32x2 v = *(const u32x2*)(src + (ok ? (i - 30) * PW : 0)); r[i].x = ok ? v.x : 0u; r[i].y = ok ? v.y : 0u; }
        f32x4 acc[4];
#pragma unroll
        for (int tt = 0; tt < 4; ++tt) { acc[tt] = bias;
#pragma unroll
            for (int j = 0; j < 31; ++j) { const u32x2 v = r[tt + j]; f32x4 x; x[0] = bf_lo(v.x); x[1] = bf_hi(v.x); x[2] = bf_lo(v.y); x[3] = bf_hi(v.y); acc[tt] += w[j] * x; } }
        float mean[4], var[4];
#pragma unroll
        for (int tt = 0; tt < 4; ++tt) mean[tt] = (acc[tt][0] + acc[tt][1]) + (acc[tt][2] + acc[tt][3]);
#pragma unroll
        for (int o = 1; o < 64; o <<= 1) {
#pragma unroll
            for (int tt = 0; tt < 4; ++tt) mean[tt] += __shfl_xor(mean[tt], o); }
#pragma unroll
        for (int tt = 0; tt < 4; ++tt) { mean[tt] *= (1.0f / 256.0f); acc[tt] -= mean[tt]; var[tt] = (acc[tt][0] * acc[tt][0] + acc[tt][1] * acc[tt][1]) + (acc[tt][2] * acc[tt][2] + acc[tt][3] * acc[tt][3]); }
#pragma unroll
        for (int o = 1; o < 64; o <<= 1) {
#pragma unroll
            for (int tt = 0; tt < 4; ++tt) var[tt] += __shfl_xor(var[tt], o); }
#pragma unroll
        for (int tt = 0; tt < 4; ++tt) {
            const float rs = 1.0f / sqrtf(var[tt] * (1.0f / 256.0f) + 1e-6f);
            const f32x4 y = pg8::silu4(acc[tt] * rs * g4 + b4);
            u32x2 o; o.x = pk2(y[0], y[1]); o.y = pk2(y[2], y[3]);
            *(u32x2*)(Y + (size_t)(tok + tt) * DM + Y_CV + 4 * lane) = o;
        }
    }
}

#define RET_STAGE(img_, gbase_, pitch_) do { \
    u32x4 r_[8]; \
    _Pragma("unroll") for (int i_ = 0; i_ < 8; ++i_) r_[i_] = *(const u32x4*)((gbase_) + (size_t)(8 * i_ + (lane >> 3)) * (pitch_) + 8 * (lane & 7)); \
    _Pragma("unroll") for (int i_ = 0; i_ < 8; ++i_) { const int rr_ = 8 * i_ + (lane >> 3); *(LAS u32x4*)((img_) + rr_ * 128 + (((lane & 7) ^ ((rr_ >> 1) & 7)) << 4)) = r_[i_]; } } while (0)
#define RET_STAGE_LOAD(r_, n_, gbase_, pitch_) do { _Pragma("unroll") for (int i_ = 0; i_ < (n_); ++i_) r_[i_] = *(const u32x4*)((gbase_) + (size_t)(8 * i_ + (lane >> 3)) * (pitch_) + 8 * (lane & 7)); } while (0)
#define RET_STAGE_STORE(img_, r_, n_) do { _Pragma("unroll") for (int i_ = 0; i_ < (n_); ++i_) { const int rr_ = 8 * i_ + (lane >> 3); *(LAS u32x4*)((img_) + rr_ * 128 + (((lane & 7) ^ ((rr_ >> 1) & 7)) << 4)) = r_[i_]; } } while (0)
#define RET_FRAG(img_, row_, chunk_) (*(const LAS bfx8*)((img_) + (row_) * 128 + (((chunk_) ^ (((row_) >> 1) & 7)) << 4)))
#define RET_UPDATE(kimg_, vimg_) do { \
    _Pragma("unroll") for (int js = 0; js < 4; ++js) { \
        const bfx8 a0_ = RET_FRAG(kimg_, n, 2 * js + hi), a1_ = RET_FRAG(kimg_, 32 + n, 2 * js + hi), b0_ = RET_FRAG(vimg_, n, 2 * js + hi), b1_ = RET_FRAG(vimg_, 32 + n, 2 * js + hi); \
        st00 = MFMA32(a0_, b0_, st00); st01 = MFMA32(a0_, b1_, st01); st10 = MFMA32(a1_, b0_, st10); st11 = MFMA32(a1_, b1_, st11); } } while (0)

DI void ret1_unit(int item, const bf16_t* __restrict__ T, float* __restrict__ G, int lane, LAS unsigned char* wl) {
    const int g = item % NG, bh = item / NG, b = bh >> 2, h = bh & 3;
    const int n = lane & 31, hi = lane >> 5;
    const float cd = EXP2(lgamma2(h) * 64.0f);
    f32x16 st00 = zero16(), st01 = zero16(), st10 = zero16(), st11 = zero16();
    for (int c = 0; c < GC; ++c) {
        const size_t tb = (size_t)b * SEQ + (size_t)(g * GC + c) * 64;
        if (c > 0) { st00 *= cd; st01 *= cd; st10 *= cd; st11 *= cd; }
        RET_STAGE(wl, T + (size_t)(T_KR + h * 64) * LDT + tb, LDT); RET_STAGE(wl + 8192, T + (size_t)(T_VR + h * 64) * LDT + tb, LDT);
        RET_UPDATE(wl, wl + 8192);
    }
    f32x4* gp = (f32x4*)(G + (size_t)item * 4096) + lane * 4;
#pragma unroll
    for (int q = 0; q < 4; ++q) {
        gp[q] = (f32x4){st00[4 * q], st00[4 * q + 1], st00[4 * q + 2], st00[4 * q + 3]}; gp[256 + q] = (f32x4){st01[4 * q], st01[4 * q + 1], st01[4 * q + 2], st01[4 * q + 3]};
        gp[512 + q] = (f32x4){st10[4 * q], st10[4 * q + 1], st10[4 * q + 2], st10[4 * q + 3]}; gp[768 + q] = (f32x4){st11[4 * q], st11[4 * q + 1], st11[4 * q + 2], st11[4 * q + 3]}; }
}

template <int PREFIX_ONLY> DI void ret2_unit(int item2, const bf16_t* __restrict__ P, const bf16_t* __restrict__ T, const float* __restrict__ G, bf16_t* __restrict__ Y,
                  const float* __restrict__ gain, int lane, LAS unsigned char* wl) {
    const int it = item2 & 1, item = item2 >> 1;
    const int g = item % NG, bh = item / NG, b = bh >> 2, h = bh & 3;
    const unsigned n0_ = lane & 31, hi0_ = lane >> 5;
    const float lg = lgamma2(h);
    const float cd = EXP2(lg * 64.0f), cdG = EXP2(lg * (64.0f * GC));
    f32x16 st00 = zero16(), st01 = zero16(), st10 = zero16(), st11 = zero16();
    if (g > 0) {
        const f32x4* sp = (const f32x4*)(G + (size_t)(bh * NG + g) * 4096) + lane * 4;
#pragma unroll
        for (int q = 0; q < 4; ++q) { const f32x4 a0 = sp[q], a1 = sp[256 + q], a2 = sp[512 + q], a3 = sp[768 + q];
#pragma unroll
            for (int e = 0; e < 4; ++e) { st00[4 * q + e] = a0[e]; st01[4 * q + e] = a1[e]; st10[4 * q + e] = a2[e]; st11[4 * q + e] = a3[e]; } }
    }
    if (PREFIX_ONLY == 1) { if (st00[0] + st01[1] + st10[2] + st11[3] == 12345.678f) Y[0] = 0; return; }
    const float* gn = gain + h * 64;
#pragma unroll 1
    for (int c = 0; c < (PREFIX_ONLY == 2 ? 1 : GC); ++c) {
        const size_t tb = (size_t)b * SEQ + (size_t)(g * GC + c) * 64;
        const bf16_t* Pq = P + tb * PW + P_QR + h * 64; const bf16_t* Pk = P + tb * PW + P_KR + h * 64; const bf16_t* Pg = P + tb * PW + P_GR + h * 64;
        bf16_t* Yb = Y + tb * DM + Y_R + h * 64; const bf16_t* Tv = T + (size_t)(T_VR + h * 64) * LDT + tb;
        RET_STAGE(wl, Pk, PW); RET_STAGE(wl + 8192, Tv, LDT);
        u32x4 gr[4], ktr[8];
        RET_STAGE_LOAD(gr, 4, Pg + (size_t)(32 * it) * PW, PW);
        if (c + 1 < GC) RET_STAGE_LOAD(ktr, 8, T + (size_t)(T_KR + h * 64) * LDT + tb, LDT);
        {
            unsigned n = n0_, hi = hi0_; asm volatile("" : "+v"(n), "+v"(hi));
            const unsigned ov = n * (unsigned)LDT + 4u * hi;
            const unsigned il = 32u * it + n, oq = il * PW;
            f32x16 y0 = zero16(), y1 = zero16();
            { const bfx8 q0 = ld44(Pq + (oq + 4 * hi)), q1 = ld44(Pq + (oq + 16 + 4 * hi)), q2 = ld44(Pq + (oq + 32 + 4 * hi)), q3 = ld44(Pq + (oq + 48 + 4 * hi));
              y0 = MFMA32(pack8<0>(st00), q0, y0); y1 = MFMA32(pack8<0>(st01), q0, y1);
              y0 = MFMA32(pack8<1>(st00), q1, y0); y1 = MFMA32(pack8<1>(st01), q1, y1);
              y0 = MFMA32(pack8<0>(st10), q2, y0); y1 = MFMA32(pack8<0>(st11), q2, y1);
              y0 = MFMA32(pack8<1>(st10), q3, y0); y1 = MFMA32(pack8<1>(st11), q3, y1); }

            const float qdec = EXP2(lg * (float)(il + 1));
            y0 *= qdec; y1 *= qdec;
            f32x16 sc0 = zero16(), sc1 = zero16();
            { const unsigned ok = n * PW + 8 * hi;
#pragma unroll
              for (int kk = 0; kk < 4; ++kk) { const bfx8 qn = ld8(Pq + (oq + 16 * kk + 8 * hi)); const bfx8 k0 = RET_FRAG(wl, n, 2 * kk + hi), k1 = RET_FRAG(wl, 32 + n, 2 * kk + hi);
                  sc0 = MFMA32(k0, qn, sc0); sc1 = MFMA32(k1, qn, sc1);  } }

#pragma unroll
            for (int i = 0; i < 16; ++i) { const int j0 = crow(i, hi); sc0[i] *= EXP2(lg * fabsf((float)((int)il - j0))); sc1[i] *= EXP2(lg * fabsf((float)((int)il - j0 - 32))); }
            { const LAS unsigned char* vimg = wl + 8192;
              { const bfx8 w = pack8<0>(sc0); y0 = MFMA32(lds44(vimg, n, 0, hi), w, y0); y1 = MFMA32(lds44(vimg, 32 + n, 0, hi), w, y1); }
              { const bfx8 w = pack8<1>(sc0); y0 = MFMA32(lds44(vimg, n, 1, hi), w, y0); y1 = MFMA32(lds44(vimg, 32 + n, 1, hi), w, y1); }
              { const bfx8 w = pack8<0>(sc1); y0 = MFMA32(lds44(vimg, n, 2, hi), w, y0); y1 = MFMA32(lds44(vimg, 32 + n, 2, hi), w, y1); }
              { const bfx8 w = pack8<1>(sc1); y0 = MFMA32(lds44(vimg, n, 3, hi), w, y0); y1 = MFMA32(lds44(vimg, 32 + n, 3, hi), w, y1); } }
            float sum = 0.f;
#pragma unroll
            for (int i = 0; i < 16; ++i) sum += y0[i] + y1[i];
            sum += __shfl_xor(sum, 32);
            const float mean = sum * (1.0f / 64.0f);
            float sq = 0.f;
#pragma unroll
            for (int i = 0; i < 16; ++i) { y0[i] -= mean; y1[i] -= mean; sq += y0[i] * y0[i] + y1[i] * y1[i]; }
            sq += __shfl_xor(sq, 32);
            const float rs = 1.0f / sqrtf(sq * (1.0f / 64.0f) + 1e-6f);
            { const int srow = lane >> 3, sch = lane & 7;
              RET_STAGE_STORE(wl, gr, 4);
#pragma unroll
              for (int q = 0; q < 4; ++q) {
                { const u32x2 gv = *(const LAS u32x2*)(wl + n * 128 + (((q) ^ ((n >> 1) & 7)) << 4) + 8 * hi); const f32x4 gg = *(const f32x4*)(gn + (4 * hi + 8 * q));
                  const float g0 = bf_lo(gv.x), g1 = bf_hi(gv.x), g2 = bf_lo(gv.y), g3 = bf_hi(gv.y);
                  u32x2 o; o.x = pk2(y0[4 * q] * rs * gg[0] * (g0 * pg8::sigmoid_f(g0)), y0[4 * q + 1] * rs * gg[1] * (g1 * pg8::sigmoid_f(g1)));
                  o.y = pk2(y0[4 * q + 2] * rs * gg[2] * (g2 * pg8::sigmoid_f(g2)), y0[4 * q + 3] * rs * gg[3] * (g3 * pg8::sigmoid_f(g3)));
                  *(LAS u32x2*)(wl + 4096 + n * 128 + (((q) ^ ((n >> 1) & 7)) << 4) + 8 * hi) = o; }
                { const u32x2 gv = *(const LAS u32x2*)(wl + n * 128 + (((4 + q) ^ ((n >> 1) & 7)) << 4) + 8 * hi); const f32x4 gg = *(const f32x4*)(gn + (4 * hi + 32 + 8 * q));
                  const float g0 = bf_lo(gv.x), g1 = bf_hi(gv.x), g2 = bf_lo(gv.y), g3 = bf_hi(gv.y);
                  u32x2 o; o.x = pk2(y1[4 * q] * rs * gg[0] * (g0 * pg8::sigmoid_f(g0)), y1[4 * q + 1] * rs * gg[1] * (g1 * pg8::sigmoid_f(g1)));
                  o.y = pk2(y1[4 * q + 2] * rs * gg[2] * (g2 * pg8::sigmoid_f(g2)), y1[4 * q + 3] * rs * gg[3] * (g3 * pg8::sigmoid_f(g3)));
                  *(LAS u32x2*)(wl + 4096 + n * 128 + (((4 + q) ^ ((n >> 1) & 7)) << 4) + 8 * hi) = o; }
              }
              bf16_t* yg = Yb + (size_t)(32 * it + srow) * DM + 8 * sch;
#pragma unroll
              for (int i = 0; i < 4; ++i) { const int r = 8 * i + srow; *(u32x4*)(yg + (size_t)(8 * i) * DM) = *(const LAS u32x4*)(wl + 4096 + r * 128 + ((sch ^ ((r >> 1) & 7)) << 4)); }
            }
        }
        if (c + 1 < GC) { unsigned n = n0_, hi = hi0_; asm volatile("" : "+v"(n), "+v"(hi)); st00 *= cd; st01 *= cd; st10 *= cd; st11 *= cd;
            RET_STAGE_STORE(wl, ktr, 8); RET_UPDATE(wl, wl + 8192); }
    }
}

struct TrItem { const float* src; const float* gain; bf16_t* dst; int N, K, k0, drow0; };
DI void tr_load(const TrItem& t, float (&v)[32], int lane) {
    const float* p = t.src + (size_t)(t.k0 + (lane >> 5)) * t.N + (lane & 31);
#pragma unroll
    for (int i = 0; i < 32; ++i) v[i] = __builtin_nontemporal_load(p + (size_t)(2 * i) * t.N);
}
DI void tr_store(const TrItem& t, const float (&v)[32], LAS float* scr, int lane) {
#pragma unroll
    for (int i = 0; i < 32; ++i) scr[(2 * i + (lane >> 5)) * 33 + (lane & 31)] = v[i];
    asm volatile("s_waitcnt lgkmcnt(0)" ::: "memory");
    const int c = lane & 7;
    f32x4 g0 = {1.f, 1.f, 1.f, 1.f}, g1 = g0;
    if (t.gain) { g0 = *(const f32x4*)(t.gain + t.k0 + 8 * c); g1 = *(const f32x4*)(t.gain + t.k0 + 8 * c + 4); }
#pragma unroll
    for (int j = 0; j < 4; ++j) { const int nn = (lane >> 3) + 8 * j; const LAS float* s = scr + (8 * c) * 33 + nn;
        u32x4 o; o.x = pk2(s[0 * 33] * g0[0], s[1 * 33] * g0[1]); o.y = pk2(s[2 * 33] * g0[2], s[3 * 33] * g0[3]); o.z = pk2(s[4 * 33] * g1[0], s[5 * 33] * g1[1]); o.w = pk2(s[6 * 33] * g1[2], s[7 * 33] * g1[3]);
        *(u32x4*)(t.dst + (size_t)(t.drow0 + nn) * t.K + t.k0 + 8 * c) = o; }
    asm volatile("s_waitcnt lgkmcnt(0)" ::: "memory");
}
DI int srcmap(int type, int n0) {
    const int tile = n0 >> 8, c = n0 & 255, bj = c >> 7, p = c & 127;
    if (type == 0) return bj * FF + 128 * tile + p;
    if (type == 1) return n0;
    if (type == 2) {
        if (tile < 2) return bj * 256 + 128 * tile + p;
        if (tile < 6) return 512 + 256 * (tile - 2) + c;
        if (tile == 6) return 2048 + (p >> 5) * 64 + 32 * bj + (p & 31);
        if (tile == 7) return 2304 + (p >> 5) * 64 + 32 * bj + (p & 31);
        return 2816 + c;
    }
    if (tile < 2) return 1536 + n0;
    if (tile == 2) return 2560 + c;
    return 2304 + (p >> 5) * 64 + 32 * bj + (p & 31);
}

#define XB_TMO      128
#define XB_XCNT(j)  (256  + 64 * (j))
#define XB_XSUB(j)  (1280 + 64 * (j))
#define XB_XGEN(j)  (2304 + 64 * (j))
#define XB_TOP      3328
#define XB_TOPGEN   3392
#define XCD_BAR_WORDS 3456
#define XB_SPIN_CAP (1u << 18)

__device__ __forceinline__ unsigned xb_ld(unsigned* p)              { return __hip_atomic_load(p, __ATOMIC_RELAXED, __HIP_MEMORY_SCOPE_AGENT); }
__device__ __forceinline__ unsigned xb_add(unsigned* p, unsigned v) { return __hip_atomic_fetch_add(p, v, __ATOMIC_RELAXED, __HIP_MEMORY_SCOPE_AGENT); }
__device__ __forceinline__ unsigned xb_xcc_id() { return (unsigned)__builtin_amdgcn_s_getreg((3 << 11) | 20) & 0xFu; }
#define XB_SPIN(cond, bar) do { unsigned _sp = 0; while (cond) { __builtin_amdgcn_s_sleep(1); \
    if ((++_sp & 255u) == 0u) { if (xb_ld(&(bar)[XB_TMO])) break; if (_sp > XB_SPIN_CAP) { atomicAdd(&(bar)[XB_TMO], 1u); break; } } } } while (0)

struct XcdBarrier {
    unsigned* bar; unsigned x;
    volatile LAS unsigned* st;
};

__device__ __forceinline__ XcdBarrier xcd_barrier_post(unsigned* bar, volatile LAS unsigned* st) {
    XcdBarrier b; b.bar = bar; b.x = xb_xcc_id(); b.st = st;
    if (threadIdx.x == 0) (void)xb_add(&bar[XB_XCNT(b.x)], 1u);
    return b;
}
__device__ __forceinline__ void xcd_barrier_complete(unsigned* bar, unsigned x, unsigned& nloc, unsigned& nx) {
    const unsigned G = gridDim.x * gridDim.y * gridDim.z;
    unsigned sum, cnt, mine, sp = 0u;
    for (;;) {
        sum = 0u; cnt = 0u; mine = 0u;
#pragma unroll
        for (unsigned j = 0; j < 16; ++j) { const unsigned c = xb_ld(&bar[XB_XCNT(j)]); sum += c; cnt += (c > 0u) ? 1u : 0u; mine = (j == x) ? c : mine; }
        if (sum == G) break;
        __builtin_amdgcn_s_sleep(1);
        if ((++sp & 255u) == 0u) { if (xb_ld(&bar[XB_TMO])) break; if (sp > XB_SPIN_CAP) { atomicAdd(&bar[XB_TMO], 1u); break; } }
    }
    nloc = mine > 0u ? mine : 1u; nx = cnt > 0u ? cnt : 1u;
}

__device__ __forceinline__ void xcd_barrier(const XcdBarrier& b) {
    asm volatile("s_waitcnt vmcnt(0)" ::: "memory");
    __syncthreads();
    if (threadIdx.x == 0) {
        unsigned* bar = b.bar;
        __builtin_amdgcn_s_waitcnt(0);
        unsigned nloc = b.st[0], nx = b.st[1];
        if (nloc == 0u) { xcd_barrier_complete(bar, b.x, nloc, nx); b.st[0] = nloc; b.st[1] = nx; }
        const unsigned old = xb_add(&bar[XB_XSUB(b.x)], 1u);
        const unsigned gen = old / nloc;
        if (old + 1u == (gen + 1u) * nloc) {
            __builtin_amdgcn_fence(__ATOMIC_RELEASE, "agent");
            asm volatile("s_waitcnt vmcnt(0)" ::: "memory");
            const unsigned og = xb_add(&bar[XB_TOP], 1u);
            const unsigned tg = og / nx;
            if (og + 1u == (tg + 1u) * nx) xb_add(&bar[XB_TOPGEN], 1u);
            else XB_SPIN(xb_ld(&bar[XB_TOPGEN]) == tg, bar);
            __builtin_amdgcn_fence(__ATOMIC_ACQUIRE, "agent");
            xb_add(&bar[XB_XGEN(b.x)], 1u);
            asm volatile("s_waitcnt vmcnt(0)" ::: "memory");
        } else {
            XB_SPIN(xb_ld(&bar[XB_XGEN(b.x)]) == gen, bar);
            __builtin_amdgcn_fence(__ATOMIC_ACQUIRE, "agent");
            asm volatile("s_waitcnt vmcnt(0)" ::: "memory");
        }
    }
    __syncthreads();
}

#ifdef NO_R1
#define DO_R1(...)
#else
#define DO_R1(...) __VA_ARGS__
#endif
#ifdef NO_R2
#define DO_R2(...)
#else
#define DO_R2(...) __VA_ARGS__
#endif
#ifdef NO_SB
#define DO_SB(...)
#else
#define DO_SB(...) __VA_ARGS__
#endif
#ifdef NO_CV
#define DO_CV(...)
#else
#define DO_CV(...) __VA_ARGS__
#endif
#ifdef NO_G0
#define DO_G0(...)
#else
#define DO_G0(...) __VA_ARGS__
#endif
#ifdef NO_G1
#define DO_G1(...)
#else
#define DO_G1(...) __VA_ARGS__
#endif
#ifdef NO_G2
#define DO_G2(...)
#else
#define DO_G2(...) __VA_ARGS__
#endif
#ifdef NO_G3
#define DO_G3(...)
#else
#define DO_G3(...) __VA_ARGS__
#endif

#ifndef P2_PROBE
#define P2_PROBE 3
#endif
#ifndef MI_PROBE
#define MI_PROBE 3
#endif
#ifndef PRO_PART
#define PRO_PART 7
#endif
struct Args { const float* in[16]; float* out; unsigned char* ws; int ph_lo, ph_hi; };
constexpr int PPL = 9, N_PHASES = 2 + PPL * DEPTH;
constexpr int RS_OFF = 131072;

constexpr int RS_SLOTS = 12;
DI void fill_rowscales(const pg8::StaticOrder& S, const float* SS, LAS float* rs, int bycol) {
    pg8::Unit u;
    for (int ui = 0; ui < RS_SLOTS && S.next(ui, u); ++ui) {
        const int t = threadIdx.x;
        if (t < 256) rs[ui * 256 + t] = pg8::rowscale(SS, (bycol ? u.pn : u.pm) * 256 + t);
    }
    __syncthreads();
}

DI TrItem tr_decode(const Args& a, unsigned char* ws, int it) {
    constexpr int I0 = 16 * (NFF / 32), I1 = (FF / 64) * 32, I2 = 16 * 72, I3 = 16 * 32, I4 = 16 * 32, IL = 2 * I0 + 2 * I1 + I2 + I3 + I4;
    const int l = it / IL; int r = it % IL;
    unsigned char* wb = ws + WS_W + (size_t)l * W_STRIDE;
    TrItem t; int type, nblk;
    if (r < I0) { t.src = a.in[2] + (size_t)l * DM * NFF; t.gain = a.in[1] + l * DM; t.dst = (bf16_t*)(wb + WO_1I); t.N = NFF; t.K = DM; type = 0; nblk = NFF / 32; }
    else if ((r -= I0) < I1) { t.src = a.in[3] + (size_t)l * FF * DM; t.gain = nullptr; t.dst = (bf16_t*)(wb + WO_1O); t.N = DM; t.K = FF; type = 1; nblk = 32; }
    else if ((r -= I1) < I2) { t.src = a.in[5] + (size_t)l * DM * NMIX; t.gain = a.in[4] + l * DM; t.dst = (bf16_t*)(wb + WO_MN); t.N = NMIX; t.K = DM; type = 2; nblk = 72; }
    else if ((r -= I2) < I3) { t.src = a.in[5] + (size_t)l * DM * NMIX; t.gain = a.in[4] + l * DM; t.dst = (bf16_t*)(wb + WO_MT); t.N = NMIX; t.K = DM; type = 3; nblk = 32; }
    else if ((r -= I3) < I4) { t.src = a.in[11] + (size_t)l * DM * DM; t.gain = nullptr; t.dst = (bf16_t*)(wb + WO_MO); t.N = DM; t.K = DM; type = 1; nblk = 32; }
    else if ((r -= I4) < I0) { t.src = a.in[13] + (size_t)l * DM * NFF; t.gain = a.in[12] + l * DM; t.dst = (bf16_t*)(wb + WO_2I); t.N = NFF; t.K = DM; type = 0; nblk = NFF / 32; }
    else { r -= I0; t.src = a.in[14] + (size_t)l * FF * DM; t.gain = nullptr; t.dst = (bf16_t*)(wb + WO_2O); t.N = DM; t.K = FF; type = 1; nblk = 32; }
    const int kb = r / nblk, nb = r % nblk;
    t.src += srcmap(type, nb * 32); t.drow0 = nb * 32; t.k0 = kb * 64;
    return t;
}

DI void convert_weights(const Args& a, unsigned char* ws, LAS float* scr, int lane, int gw, int NGW, int it_lo, int it_hi) {
    float va[32], vb[32];
    int it = it_lo + gw;
    TrItem ta{}, tb{};
    if (it < it_hi) { ta = tr_decode(a, ws, it); tr_load(ta, va, lane); }
    while (it < it_hi) {
        const int itb = it + NGW, ita = it + 2 * NGW;
        if (itb < it_hi) { tb = tr_decode(a, ws, itb); tr_load(tb, vb, lane); }
        tr_store(ta, va, scr, lane);
        if (itb >= it_hi) break;
        if (ita < it_hi) { ta = tr_decode(a, ws, ita); tr_load(ta, va, lane); }
        tr_store(tb, vb, scr, lane);
        it = ita;
    }
}

template <int PH, int REP = 0> DI void run_phase(const Args& a, LAS unsigned char* lds, const int lane, const int wave) {
    const int G = gridDim.x, gw = blockIdx.x * NWAVES + wave, NGW = G * NWAVES;
    unsigned char* ws = a.ws;
    LAS float* rs = (LAS float*)(lds + RS_OFF);
    if constexpr (PH == 0) {
        LAS float* scr = (LAS float*)(lds + wave * 16384);
        constexpr int I0 = 16 * (NFF / 32), I1 = (FF / 64) * 32, I2 = 16 * 72, I3 = 16 * 32, I4 = 16 * 32, IL = 2 * I0 + 2 * I1 + I2 + I3 + I4;
        if (!REP || (PRO_PART & 1)) convert_weights(a, ws, scr, lane, gw, NGW, 0, IL);
        { float* SS = (float*)(ws + WS_SS); bf16_t* XB = (bf16_t*)(ws + WS_XB);
          if (!REP || (PRO_PART & 2)) for (int m = gw; m < M_TOK; m += NGW) {
            const f32x4* xr = (const f32x4*)(a.in[0] + (size_t)m * DM) + lane; float s = 0.f;
            unsigned long long* o8 = (unsigned long long*)(XB + (size_t)m * DM) + lane;
#pragma unroll
            for (int j = 0; j < 4; ++j) { const f32x4 v = __builtin_nontemporal_load(xr + 64 * j); s += (v[0] * v[0] + v[1] * v[1]) + (v[2] * v[2] + v[3] * v[3]);
                o8[64 * j] = (unsigned long long)pk2(v[0], v[1]) | ((unsigned long long)pk2(v[2], v[3]) << 32); }
            s = wave_sum(s);
            if (lane < 16) SS[(size_t)m * 16 + lane] = (lane == 0) ? s : 0.f;
          } }
        { float* cosT = (float*)(ws + WS_ROT); float* sinT = cosT + 262144; float* cosTT = sinT + 262144; float* sinTT = cosTT + 262144;
          if (!REP || (PRO_PART & 4)) for (int idx = blockIdx.x * NTHR + threadIdx.x; idx < 262144; idx += G * NTHR) {
            const int pos = idx >> 5, dd = idx & 31;
            double inv = 0.15915494309189535;
            for (int q = 0; q < dd; ++q) inv *= 0.7498942093324558;
            const double rev = (double)pos * inv; const float fr = (float)(rev - __builtin_floor(rev));
            const float cv = __builtin_amdgcn_cosf(fr), sv = __builtin_amdgcn_sinf(fr);
            cosT[idx] = cv; sinT[idx] = sv; cosTT[dd * 8192 + pos] = cv; sinTT[dd * 8192 + pos] = sv;
          } }
    } else if constexpr (PH == N_PHASES - 1) {
        const float* fg = a.in[15]; const float* SS = (const float*)(ws + WS_SS); float* X = a.out; const bf16_t* XB = (const bf16_t*)(ws + WS_XB);
        for (int m = gw; m < M_TOK; m += NGW) {
            const float r = pg8::rowscale(SS, m);
            const u32x2* xr = (const u32x2*)(XB + (size_t)m * DM) + lane; f32x4* orow = (f32x4*)(X + (size_t)m * DM) + lane; const f32x4* gr = (const f32x4*)fg + lane;
#pragma unroll
            for (int j = 0; j < 4; ++j) { const u32x2 w = xr[64 * j]; const f32x4 v = {bf_lo(w.x), bf_hi(w.x), bf_lo(w.y), bf_hi(w.y)}; __builtin_nontemporal_store(v * r * gr[64 * j], orow + 64 * j); }
        }
    } else {
        constexpr int l = (PH - 1) / PPL, s = (PH - 1) % PPL;
        unsigned char* wb = ws + WS_W + (size_t)l * W_STRIDE;
        if constexpr (s == 0 || s == 7) {
            pg8::Gemm g{(const bf16_t*)(ws + WS_XB), (const bf16_t*)(wb + (s == 0 ? WO_1I : WO_2I)), M_TOK, NFF, DM};
            pg8::StaticOrder S; S.init(M_TOK, NFF, G, (int)blockIdx.x); fill_rowscales(S, (const float*)(ws + WS_SS), rs, 0);
            pg8::EpiSwiGLU E{(bf16_t*)(ws + WS_H), rs, FF};
            DO_G0(pg8::gemm_phase<pg8::EpiSwiGLU, pg8::StaticOrder, true, true>(lds, g, S, E));
        } else if constexpr (s == 1 || s == 6 || s == 8) {
            pg8::Gemm g{(const bf16_t*)(ws + (s == 6 ? WS_Y : WS_H)), (const bf16_t*)(wb + (s == 1 ? WO_1O : s == 6 ? WO_MO : WO_2O)), M_TOK, DM, (s == 6) ? DM : FF};
            pg8::StaticOrder S; S.init(M_TOK, DM, G, (int)blockIdx.x);
            pg8::EpiResid E{(bf16_t*)(ws + WS_XB), (float*)(ws + WS_SS), (s == 6) ? 1.0f : 0.5f};
            DO_G1(pg8::gemm_phase<pg8::EpiResid, pg8::StaticOrder, true, true>(lds, g, S, E));
        } else if constexpr (s == 2) {
            const float* cosT = (const float*)(ws + WS_ROT);
            { pg8::Gemm g{(const bf16_t*)(ws + WS_XB), (const bf16_t*)(wb + WO_MN), M_TOK, 2304, DM};
              pg8::StaticOrder S; S.init(M_TOK, 2304, G, (int)blockIdx.x); fill_rowscales(S, (const float*)(ws + WS_SS), rs, 0);
              pg8::EpiMixN E{(bf16_t*)(ws + WS_H), rs, cosT, cosT + 262144, PW};
              if (!REP || (MI_PROBE & 1)) DO_G2(pg8::gemm_phase<pg8::EpiMixN, pg8::StaticOrder, true, true>(lds, g, S, E)); }
            { pg8::Gemm g{(const bf16_t*)(wb + WO_MT), (const bf16_t*)(ws + WS_XB), 1024, M_TOK, DM};
              pg8::StaticOrder S; S.init(1024, M_TOK, G, (int)blockIdx.x); __syncthreads(); fill_rowscales(S, (const float*)(ws + WS_SS), rs, 1);
              pg8::EpiMixT E{(bf16_t*)(ws + WS_T), rs, cosT + 2 * 262144, cosT + 3 * 262144, LDT};
              if (!REP || (MI_PROBE & 2)) DO_G3(pg8::gemm_phase<pg8::EpiMixT, pg8::StaticOrder, true, true>(lds, g, S, E)); }
        } else if constexpr (s == 3) {
            constexpr int N_R1 = 16 * NG, N_SB = SB_PART1, N_CV = M_TOK / 16, NTOT = N_R1 + N_SB + N_CV;
            const bf16_t* P = (const bf16_t*)(ws + WS_H); const bf16_t* T = (const bf16_t*)(ws + WS_T); bf16_t* Y = (bf16_t*)(ws + WS_Y);
            if (N_SB == 0 && NWAVES == 8 && 8 * G == N_CV && 2 * G == N_R1) {
                const int bid = (G % 8 == 0) ? ((int)blockIdx.x % 8) * (G / 8) + (int)blockIdx.x / 8 : (int)blockIdx.x;
                if (wave < 2) { int ln = lane; asm volatile("" : "+v"(ln) :: "memory"); DO_R1(ret1_unit(bid * 2 + wave, T, (float*)(ws + WS_G), ln, lds + wave * 16384)); }
                { int ln = lane; asm volatile("" : "+v"(ln) :: "memory"); DO_CV(conv_unit(bid * 8 + wave, P, Y, a.in[6] + l * 31 * 256, a.in[7] + l * 256, a.in[8] + l * 256, a.in[9] + l * 256, ln)); }
            } else {
            const int gwp = wave * G + (int)blockIdx.x;
            for (int it = gwp; it < NTOT; it += NGW) {
                int ln = lane; asm volatile("" : "+v"(ln) :: "memory");
                if (it < N_R1) { DO_R1(ret1_unit(it, T, (float*)(ws + WS_G), ln, lds + wave * 16384)); }
                else if (it < N_R1 + N_SB) { DO_SB(sb_unit(it - N_R1, P, T, Y, ln, lds + wave * 16384)); }
                else { DO_CV(conv_unit(it - N_R1 - N_SB, P, Y, a.in[6] + l * 31 * 256, a.in[7] + l * 256, a.in[8] + l * 256, a.in[9] + l * 256, ln)); }
            }
            }
            if constexpr (l == 0 && DEPTH > 1 && !REP) {
                constexpr int I0 = 16 * (NFF / 32), I1 = (FF / 64) * 32, I2 = 16 * 72, I3 = 16 * 32, I4 = 16 * 32, IL = 2 * I0 + 2 * I1 + I2 + I3 + I4;
                convert_weights(a, ws, (LAS float*)(lds + wave * 16384), lane, gw, NGW, IL, DEPTH * IL);
            }
        } else if constexpr (s == 4) {
            const float* GB = (const float*)(ws + WS_G); float* SP = (float*)(ws + WS_SP);
            for (int idx = blockIdx.x * NTHR + threadIdx.x; idx < 16 * 4096; idx += G * NTHR) {
                const int bh = idx >> 12, e = idx & 4095;
                const float cdG = EXP2(lgamma2(bh & 3) * (64.0f * GC));
                const float* gp = GB + (size_t)(bh * NG) * 4096 + e; float* sp = SP + (size_t)(bh * NG) * 4096 + e;
                float v[NG - 1];
#pragma unroll
                for (int g = 0; g < NG - 1; ++g) v[g] = gp[(size_t)g * 4096];
                float st = 0.f;
#pragma unroll
                for (int g = 0; g < NG - 1; ++g) { st = st * cdG + v[g]; sp[(size_t)(g + 1) * 4096] = st; }
            }
        } else {
            constexpr int N_R2 = 2 * 16 * NG, N_SB = 4096 - SB_PART1;
            const bf16_t* P = (const bf16_t*)(ws + WS_H); const bf16_t* T = (const bf16_t*)(ws + WS_T); bf16_t* Y = (bf16_t*)(ws + WS_Y);
            if (NWAVES == 8 && NGW >= 2048) {
                const int bid = (G % 8 == 0) ? ((int)blockIdx.x % 8) * (G / 8) + (int)blockIdx.x / 8 : (int)blockIdx.x;
                if (wave < 4) {
                    for (int it = bid * 4 + wave; it < N_R2; it += 4 * G) {
                        int ln = lane; asm volatile("" : "+v"(ln) :: "memory");
                        if (!REP || (P2_PROBE & 1)) DO_R2(ret2_unit<(REP && (P2_PROBE & 4)) ? 1 : (REP && (P2_PROBE & 8)) ? 2 : 0>(it, P, T, (const float*)(ws + WS_SP), Y, a.in[10] + l * 256, ln, lds + wave * 16384));
                    }
                    const int nmain = 12 * G < N_SB ? 12 * G : N_SB;
                    if (!REP || (P2_PROBE & 2)) for (int it = nmain + bid * 4 + wave; it < N_SB; it += 4 * G) {
                        int ln = lane; asm volatile("" : "+v"(ln) :: "memory");
                        DO_SB(sb_unit(SB_PART1 + it, P, T, Y, ln, lds + wave * 16384));
                    }
                } else {
                    const int nmain = 12 * G < N_SB ? 12 * G : N_SB;
                    if (!REP || (P2_PROBE & 2)) for (int k = 0; k < 3; ++k) {
                        const int it = bid * 12 + 4 * k + (wave - 4);
                        if (it < nmain) { int ln = lane; asm volatile("" : "+v"(ln) :: "memory"); DO_SB(sb_unit(SB_PART1 + it, P, T, Y, ln, lds + wave * 16384)); }
                    }
                    if (12 * G < N_SB && G * 4 < N_SB - 12 * G) {
                        for (int it = 12 * G + 4 * G + bid * 4 + (wave - 4); it < N_SB; it += 4 * G) { int ln = lane; asm volatile("" : "+v"(ln) :: "memory"); DO_SB(sb_unit(SB_PART1 + it, P, T, Y, ln, lds + wave * 16384)); }
                    }
                }
            } else {
                const int gwp = wave * G + (int)blockIdx.x;
                for (int it = gwp; it < N_R2; it += NGW) { int ln = lane; asm volatile("" : "+v"(ln) :: "memory"); DO_R2(ret2_unit<0>(it, P, T, (const float*)(ws + WS_SP), Y, a.in[10] + l * 256, ln, lds + wave * 16384)); }
                for (int it = gwp; it < N_SB; it += NGW) { int ln = lane; asm volatile("" : "+v"(ln) :: "memory"); DO_SB(sb_unit(SB_PART1 + it, P, T, Y, ln, lds + wave * 16384)); }
            }
        }
    }
}

__global__ void __launch_bounds__(NTHR, 2) mk_fwd(Args a) {
    extern __shared__ __attribute__((aligned(16))) unsigned char lds_raw[];
    LAS unsigned char* lds = (LAS unsigned char*)lds_raw;
    cg::grid_group grid = cg::this_grid();
    const int lane = threadIdx.x & 63, wave = __builtin_amdgcn_readfirstlane(threadIdx.x >> 6);
    const int lo = a.ph_lo, hi = a.ph_hi;
    volatile LAS unsigned* bst = (volatile LAS unsigned*)(lds + RS_OFF + RS_SLOTS * 1024);
    if (threadIdx.x < 2) bst[threadIdx.x] = 0u;
    __syncthreads();
    XcdBarrier bar; bar.bar = (unsigned*)(a.ws + WS_CTL) + 4096; bar.x = 0; bar.st = bst;
    if (hi - lo > 1) bar = xcd_barrier_post((unsigned*)(a.ws + WS_CTL) + 4096, bst);
#ifndef REP_MASK
#define REP_MASK 0
#endif
    if (hi - lo > 1) grid.sync();
#define SEAM(k) xcd_barrier(bar)
#define PHASE(k) if (lo <= (k) && (k) < hi) { if ((k) > lo) SEAM(k); run_phase<(k)>(a, lds, lane, wave); if constexpr ((REP_MASK >> (k)) & 1) { xcd_barrier(bar); run_phase<(k), 1>(a, lds, lane, wave); } }
    PHASE(0)
#ifdef EXTRA_SYNCS
    for (int i = 0; i < EXTRA_SYNCS; ++i) xcd_barrier(bar);
#endif
    PHASE(1) PHASE(2) PHASE(3) PHASE(4) PHASE(5) PHASE(6) PHASE(7) PHASE(8) PHASE(9) PHASE(10) PHASE(11) PHASE(12) PHASE(13) PHASE(14) PHASE(15) PHASE(16) PHASE(17) PHASE(18) PHASE(19)
#undef PHASE
}

#ifndef MK_SPLIT
#define MK_SPLIT 0
#endif
extern "C" void kernel_launch(void* const* d_in, const int* in_sizes, int n_in, void* d_out, int out_size, void* d_ws, size_t ws_size, hipStream_t stream) {
    static int grid = 0;
    if (grid == 0) {
        if (n_in != 16 || in_sizes[0] != M_TOK * DM || out_size != M_TOK * DM || ws_size < WS_END) { fprintf(stderr, "kernel_launch: unexpected shapes (n_in %d, in0 %d, out %d, ws %zu)\n", n_in, n_in > 0 ? in_sizes[0] : -1, out_size, ws_size); grid = -1; return; }
        int dev = 0, cus = 0, per_cu = 0;
        if (hipGetDevice(&dev) != hipSuccess || hipDeviceGetAttribute(&cus, hipDeviceAttributeMultiprocessorCount, dev) != hipSuccess) { grid = -1; return; }
        if (hipFuncSetAttribute((const void*)mk_fwd, hipFuncAttributeMaxDynamicSharedMemorySize, LDS_BYTES) != hipSuccess) { fprintf(stderr, "kernel_launch: hipFuncSetAttribute failed\n"); grid = -1; return; }
        if (hipOccupancyMaxActiveBlocksPerMultiprocessor(&per_cu, (const void*)mk_fwd, NTHR, LDS_BYTES) != hipSuccess || per_cu < 1) { fprintf(stderr, "kernel_launch: occupancy query says %d\n", per_cu); per_cu = 1; }
        (void)hipGetLastError();
        grid = cus * 1;
        if (grid * RS_SLOTS < 2816) { fprintf(stderr, "kernel_launch: %d CUs: the row-scale slots are sized for >= 235 workgroups; nothing launched\n", grid); grid = -1; return; }
    }
    if (grid < 0) return;
    (void)hipMemsetAsync((char*)d_ws + WS_CTL, 0, CTL_BYTES, stream);
    Args a{};
    for (int i = 0; i < 16; ++i) a.in[i] = (const float*)d_in[i];
    a.out = (float*)d_out; a.ws = (unsigned char*)d_ws;
#if MK_SPLIT
    for (int ph = 0; ph < N_PHASES; ++ph) {
        a.ph_lo = ph; a.ph_hi = ph + 1; void* args[] = {&a};
        hipError_t e = hipLaunchCooperativeKernel((const void*)mk_fwd, dim3(grid), dim3(NTHR), args, LDS_BYTES, stream);
        if (e != hipSuccess) { fprintf(stderr, "kernel_launch: launch %d failed: %s\n", ph, hipGetErrorString(e)); break; }
    }
#else
    a.ph_lo = 0; a.ph_hi = N_PHASES; void* args[] = {&a};
    hipError_t e = hipLaunchCooperativeKernel((const void*)mk_fwd, dim3(grid), dim3(NTHR), args, LDS_BYTES, stream);
    if (e != hipSuccess) fprintf(stderr, "kernel_launch: cooperative launch failed: %s (grid %d)\n", hipGetErrorString(e), grid);
#endif
}
```

```cpp
#ifndef MK_SPLIT
#define MK_SPLIT 0
#endif
#include <hip/hip_runtime.h>
#include <hip/hip_cooperative_groups.h>
#include <cstdio>
#include <cstdint>
namespace cg = cooperative_groups;
namespace pg8 {
#define PG8_LAS __attribute__((address_space(3)))
typedef unsigned short bf16_t;
typedef short bf16x8 __attribute__((ext_vector_type(8)));
typedef float f32x4 __attribute__((ext_vector_type(4)));
typedef unsigned u32x4 __attribute__((ext_vector_type(4)));
constexpr int BM = 256, BK = 64, HALF = 128, HTB = HALF * BK * 2  , STAGE_BYTES = 8 * HTB, NXCD = 8, WGM = 8;

__host__ __device__ __forceinline__ int lds_byte(int r, int c) { const int st = (r >> 4) * 2 + (c >> 5), rr = r & 15, cc = c & 31, ob = rr * 64 + cc * 2; return st * 1024 + (ob ^ (((ob >> 9) & 1) << 5)); }
__host__ __device__ __forceinline__ void stage_rc(int b, int& R, int& C) { const int st = b / 1024, sb = b % 1024, swz = sb ^ (((sb >> 9) & 1) << 5); R = (st >> 1) * 16 + swz / 64; C = (st & 1) * 32 + (swz % 64) / 2; }
__host__ __device__ __forceinline__ int perm32(int rho) { const int n = rho >> 4, i = rho & 15; return 8 * (i >> 2) + 4 * n + (i & 3); }

struct Unit { int pm, pn; };
struct Gemm { const bf16_t* A; const bf16_t* Bt; int M, N, K; };

struct StaticOrder {
    int nM, nN, nwg, G, c;
    __host__ __device__ void init(int M, int N, int G_, int c_) { nM = M / BM; nN = N / BM; nwg = nM * nN; G = G_; c = c_; }
    __host__ __device__ bool next(int i, Unit& u) const {
        const long L = (long)i * G + c; if (L >= nwg) return false;
        int wgid = (int)L; { const int q = nwg / NXCD, r = nwg % NXCD, xcd = wgid % NXCD, off = wgid / NXCD; wgid = (xcd < r ? xcd * (q + 1) : r * (q + 1) + (xcd - r) * q) + off; }
        const int nig = WGM * nN, gid = wgid / nig, fm = gid * WGM, gsz = (nM - fm) < WGM ? (nM - fm) : WGM;
        u.pm = fm + ((wgid % nig) % gsz); u.pn = (wgid % nig) / gsz; return true;
    }
    __device__ __forceinline__ void a_ready(const Unit&, int) const {}
    __device__ __forceinline__ void done(const Unit&) const {}
};


typedef __bf16 bfx2_t __attribute__((ext_vector_type(2)));
__device__ __forceinline__ unsigned pk2(float lo, float hi) { bfx2_t v; v.x = (__bf16)lo; v.y = (__bf16)hi; return __builtin_bit_cast(unsigned, v); }
__device__ __forceinline__ u32x4 pk8(const f32x4 a, const f32x4 b) { u32x4 w; w.x = pk2(a[0], a[1]); w.y = pk2(a[2], a[3]); w.z = pk2(b[0], b[1]); w.w = pk2(b[2], b[3]); return w; }
__device__ __forceinline__ float rowscale(const float* SS, int row) {
    const f32x4* p = (const f32x4*)(SS + (size_t)row * 16);
    const f32x4 a = p[0], b = p[1], c = p[2], d = p[3];
    const float s = ((a[0] + a[1]) + (a[2] + a[3])) + ((b[0] + b[1]) + (b[2] + b[3])) + ((c[0] + c[1]) + (c[2] + c[3])) + ((d[0] + d[1]) + (d[2] + d[3]));
    return 1.0f / sqrtf(s * (1.0f / 1024.0f) + 1e-6f);
}
__device__ __forceinline__ float sigmoid_f(float x) { return __builtin_amdgcn_rcpf(1.0f + __builtin_amdgcn_exp2f(-1.4426950408889634f * x)); }
__device__ __forceinline__ f32x4 silu4(const f32x4 g) { f32x4 o; o[0] = g[0] * sigmoid_f(g[0]); o[1] = g[1] * sigmoid_f(g[1]); o[2] = g[2] * sigmoid_f(g[2]); o[3] = g[3] * sigmoid_f(g[3]); return o; }
__device__ __forceinline__ f32x4 sig4(const f32x4 g) { f32x4 o; o[0] = sigmoid_f(g[0]); o[1] = sigmoid_f(g[1]); o[2] = sigmoid_f(g[2]); o[3] = sigmoid_f(g[3]); return o; }

struct EpiSwiGLU {
    static constexpr bool PERM = true, AFTER_DRAIN = false;
    bf16_t* H; const PG8_LAS float* rs; int ldh;
    __device__ __forceinline__ void operator()(const f32x4 (&acc)[2][2][4][2], const Unit& u, int wr, int wc, int fr, int fq, int ui) const {
        const int row0 = u.pm * BM + wr * 64 + fr, col0 = u.pn * HALF + wc * 32 + 8 * fq;
#pragma unroll
        for (int ai = 0; ai < 2; ++ai)
#pragma unroll
            for (int m = 0; m < 4; ++m) {
                const int row = row0 + ai * HALF + m * 16; const float r = rs[ui * 256 + ai * HALF + wr * 64 + m * 16 + fr];
                const f32x4 g0 = acc[ai][0][m][0] * r, g1 = acc[ai][0][m][1] * r, u0 = acc[ai][1][m][0] * r, u1 = acc[ai][1][m][1] * r;
                *(u32x4*)(H + (size_t)row * ldh + col0) = pk8(silu4(g0) * u0, silu4(g1) * u1);
            }
    }
};

struct EpiResid {
    static constexpr bool PERM = true, AFTER_DRAIN = false;
    bf16_t* xb; float* SSout; float scale;
    __device__ __forceinline__ void operator()(const f32x4 (&acc)[2][2][4][2], const Unit& u, int wr, int wc, int fr, int fq, int ui) const {
        const int row0 = u.pm * BM + wr * 64 + fr, col0 = u.pn * BM + wc * 32 + 8 * fq;
        u32x4 old[2][4][2];
#pragma unroll
        for (int ai = 0; ai < 2; ++ai)
#pragma unroll
            for (int m = 0; m < 4; ++m)
#pragma unroll
                for (int bj = 0; bj < 2; ++bj) old[ai][m][bj] = *(const u32x4*)(xb + (size_t)(row0 + ai * HALF + m * 16) * 1024 + col0 + bj * HALF);
#pragma unroll
        for (int ai = 0; ai < 2; ++ai)
#pragma unroll
            for (int m = 0; m < 4; ++m) {
                const int row = row0 + ai * HALF + m * 16; float ss = 0.f;
#pragma unroll
                for (int bj = 0; bj < 2; ++bj) {
                    const u32x4 w = old[ai][m][bj];
                    const f32x4 b0 = {__uint_as_float(w.x << 16), __uint_as_float(w.x & 0xffff0000u), __uint_as_float(w.y << 16), __uint_as_float(w.y & 0xffff0000u)};
                    const f32x4 b1 = {__uint_as_float(w.z << 16), __uint_as_float(w.z & 0xffff0000u), __uint_as_float(w.w << 16), __uint_as_float(w.w & 0xffff0000u)};
                    const f32x4 o0 = b0 + acc[ai][bj][m][0] * scale, o1 = b1 + acc[ai][bj][m][1] * scale;
                    *(u32x4*)(xb + (size_t)row * 1024 + col0 + bj * HALF) = pk8(o0, o1);
                    ss += ((o0[0] * o0[0] + o0[1] * o0[1]) + (o0[2] * o0[2] + o0[3] * o0[3])) + ((o1[0] * o1[0] + o1[1] * o1[1]) + (o1[2] * o1[2] + o1[3] * o1[3]));
                }
                ss += __shfl_xor(ss, 16); ss += __shfl_xor(ss, 32);
                if (fq == 0) SSout[(size_t)row * 16 + u.pn * 4 + wc] = ss;
            }
    }
};

struct EpiMixN {
    static constexpr bool PERM = true, AFTER_DRAIN = false;
    bf16_t* P; const PG8_LAS float* rs; const float* cosT; const float* sinT; int ldp;
    __device__ __forceinline__ void operator()(const f32x4 (&acc)[2][2][4][2], const Unit& u, int wr, int wc, int fr, int fq, int ui) const {
        const int row0 = u.pm * BM + wr * 64 + fr, pn = u.pn;
#pragma unroll
        for (int ai = 0; ai < 2; ++ai)
#pragma unroll
            for (int m = 0; m < 4; ++m) {
                const int row = row0 + ai * HALF + m * 16; const float r = rs[ui * 256 + ai * HALF + wr * 64 + m * 16 + fr];
                const f32x4 a0 = acc[ai][0][m][0] * r, a1 = acc[ai][0][m][1] * r, b0 = acc[ai][1][m][0] * r, b1 = acc[ai][1][m][1] * r;
                bf16_t* prow = P + (size_t)row * ldp;
                if (pn < 2) {
                    *(u32x4*)(prow + pn * HALF + wc * 32 + 8 * fq) = pk8(a0 * sig4(b0), a1 * sig4(b1));
                } else if (pn == 6 || pn == 7) {
                    const int pos = row & 8191; const size_t to = (size_t)pos * 32 + 8 * fq;
                    const f32x4 c0 = *(const f32x4*)(cosT + to), c1 = *(const f32x4*)(cosT + to + 4), s0 = *(const f32x4*)(sinT + to), s1 = *(const f32x4*)(sinT + to + 4);
                    const float sc = (pn == 6) ? 0.125f : 1.0f;
                    const f32x4 x0 = (a0 * c0 - b0 * s0) * sc, x1 = (a1 * c1 - b1 * s1) * sc, y0 = (a0 * s0 + b0 * c0) * sc, y1 = (a1 * s1 + b1 * c1) * sc;
                    bf16_t* q = prow + (pn == 6 ? 1280 : 1536) + wc * 64 + 8 * fq;
                    *(u32x4*)(q) = pk8(x0, x1); *(u32x4*)(q + 32) = pk8(y0, y1);
                } else {
                    bf16_t* q = prow + (pn == 8 ? 1792 : 256 + (pn - 2) * 256) + wc * 32 + 8 * fq;
                    *(u32x4*)(q) = pk8(a0, a1); *(u32x4*)(q + HALF) = pk8(b0, b1);
                }
            }
    }
};

struct EpiMixT {
    static constexpr bool PERM = true, AFTER_DRAIN = false;
    bf16_t* T; const PG8_LAS float* rs; const float* cosTT; const float* sinTT; int ldt;
    __device__ __forceinline__ void operator()(const f32x4 (&acc)[2][2][4][2], const Unit& u, int wr, int wc, int fr, int fq, int ui) const {
        const int pm = u.pm;
#pragma unroll
        for (int bj = 0; bj < 2; ++bj) {
            const int tok0 = u.pn * BM + bj * HALF + wc * 32 + 8 * fq;
            const PG8_LAS f32x4* rp = (const PG8_LAS f32x4*)(rs + ui * 256 + bj * HALF + wc * 32 + 8 * fq);
            const f32x4 r0 = rp[0], r1 = rp[1];
            if (pm < 3) {
#pragma unroll
                for (int ai = 0; ai < 2; ++ai)
#pragma unroll
                    for (int m = 0; m < 4; ++m) {
                        const int f = pm * BM + ai * HALF + wr * 64 + m * 16 + fr;
                        *(u32x4*)(T + (size_t)f * ldt + tok0) = pk8(acc[ai][bj][m][0] * r0, acc[ai][bj][m][1] * r1);
                    }
            } else {
                const int pos0 = tok0 & 8191, tk = tok0 & 63;
#pragma unroll
                for (int m = 0; m < 4; ++m) {
                    const int x = wr * 64 + m * 16 + fr, hh = x >> 5, dd = x & 31;
                    const float lg = (hh == 0) ? -0.04580368961312479f : (hh == 1) ? -0.02272007650008353f : (hh == 2) ? -0.011315313227834146f : -0.005646563141142063f;
                    f32x4 k0, k1;
#pragma unroll
                    for (int e = 0; e < 4; ++e) { k0[e] = __builtin_amdgcn_exp2f(lg * (float)(63 - tk - e)); k1[e] = __builtin_amdgcn_exp2f(lg * (float)(59 - tk - e)); }
                    const size_t to = (size_t)dd * 8192 + pos0;
                    const f32x4 c0 = *(const f32x4*)(cosTT + to), c1 = *(const f32x4*)(cosTT + to + 4), s0 = *(const f32x4*)(sinTT + to), s1 = *(const f32x4*)(sinTT + to + 4);
                    const f32x4 a0 = acc[0][bj][m][0] * r0, a1 = acc[0][bj][m][1] * r1, b0 = acc[1][bj][m][0] * r0, b1 = acc[1][bj][m][1] * r1;
                    const f32x4 x0 = (a0 * c0 - b0 * s0) * k0, x1 = (a1 * c1 - b1 * s1) * k1, y0 = (a0 * s0 + b0 * c0) * k0, y1 = (a1 * s1 + b1 * c1) * k1;
                    bf16_t* q = T + (size_t)(768 + hh * 64 + dd) * ldt + tok0;
                    *(u32x4*)(q) = pk8(x0, x1); *(u32x4*)(q + (size_t)32 * ldt) = pk8(y0, y1);
                }
            }
        }
    }
};

template <class Epi, class Sched, bool ALIGN_EPI = false, bool SP2 = false>
__device__ __forceinline__ void gemm_phase(PG8_LAS unsigned char* lds, const Gemm g, const Sched& S, const Epi& E) {
    const int tid = threadIdx.x, wid = __builtin_amdgcn_readfirstlane(tid >> 6), lane = tid & 63, wr = wid >> 2, wc = wid & 3, fr = lane & 15, fq = lane >> 4;
    const int K = g.K, nt = K / BK;
    unsigned voffA[2], voffB[2];
#pragma unroll
    for (int i = 0; i < 2; ++i) { int R, C; stage_rc(tid * 16 + i * 8192, R, C); const int Rb = Epi::PERM ? ((R & ~31) + perm32(R & 31)) : R;
        voffA[i] = (unsigned)(R * K + C) * 2u; voffB[i] = (unsigned)(Rb * K + C) * 2u; }
    const size_t kstep = (size_t)(BK * 2);
    const size_t hstep = (size_t)HALF * K * 2;
    const size_t tstep = 2 * hstep;
    const unsigned ldsw = (unsigned)wid * 1024u;
    const int aoff = lds_byte(wr * 64 + fr, fq * 8), boff = lds_byte(wc * 32 + fr, fq * 8);
#define PG8_SA(b, h) (((b) * 2 + (h)) * HTB)
#define PG8_SB(b, h) ((4 + (b) * 2 + (h)) * HTB)
#define PG8_STAGE(bufoff, gbase, voff) do { _Pragma("unroll") for (int _i = 0; _i < 2; ++_i) \
        __builtin_amdgcn_global_load_lds((const unsigned*)((const char*)(gbase) + (voff)[_i]), (PG8_LAS unsigned*)(lds + (bufoff) + ldsw + _i * 8192), 16, 0, 0); } while (0)
#define PG8_LDA(dst, b, h) do { _Pragma("unroll") for (int m = 0; m < 4; ++m) _Pragma("unroll") for (int k = 0; k < 2; ++k) dst[m][k] = *(const PG8_LAS bf16x8*)(lds + PG8_SA(b, h) + aoff + m * 2048 + k * 1024); } while (0)
#define PG8_LDB(dst, b, h) do { _Pragma("unroll") for (int n = 0; n < 2; ++n) _Pragma("unroll") for (int k = 0; k < 2; ++k) dst[n][k] = *(const PG8_LAS bf16x8*)(lds + PG8_SB(b, h) + boff + n * 2048 + k * 1024); } while (0)
#define PG8_MMA(ai, bj, At, Bt) do { __builtin_amdgcn_s_setprio(1); _Pragma("unroll") for (int m = 0; m < 4; ++m) _Pragma("unroll") for (int n = 0; n < 2; ++n) _Pragma("unroll") for (int k = 0; k < 2; ++k) \
        acc[ai][bj][m][n] = __builtin_amdgcn_mfma_f32_16x16x32_bf16(Bt[n][k], At[m][k], acc[ai][bj][m][n], 0, 0, 0); __builtin_amdgcn_s_setprio(0); } while (0)
#define PG8_WAIT_V(n) asm volatile("s_waitcnt vmcnt(" #n ")" ::: "memory")
#define PG8_WAIT_L(n) asm volatile("s_waitcnt lgkmcnt(" #n ")" ::: "memory")
#define PG8_BAR __builtin_amdgcn_s_barrier()
#define PG8_SCHED __builtin_amdgcn_sched_barrier(0)
    Unit cur, nxt; int ui = 0;
    if (!S.next(0, cur)) return;
    f32x4 acc[2][2][4][2];
#pragma unroll
    for (int a = 0; a < 2; ++a)
#pragma unroll
        for (int b = 0; b < 2; ++b)
#pragma unroll
            for (int m = 0; m < 4; ++m)
#pragma unroll
                for (int n = 0; n < 2; ++n) acc[a][b][m][n] = (f32x4){0.f, 0.f, 0.f, 0.f};
    bf16x8 At[4][2], B0[2][2], B1[2][2];
    const char* cA = (const char*)g.A + (size_t)cur.pm * tstep; const char* cB = (const char*)g.Bt + (size_t)cur.pn * tstep;
    S.a_ready(cur, 0);
    if constexpr (SP2) {
        PG8_STAGE(PG8_SB(0, 0), cB, voffB); PG8_STAGE(PG8_SB(0, 1), cB + hstep, voffB); PG8_STAGE(PG8_SA(0, 0), cA, voffA); PG8_STAGE(PG8_SA(0, 1), cA + hstep, voffA);
        if (wr == 1) PG8_BAR;
        PG8_WAIT_V(2); PG8_BAR;
        PG8_STAGE(PG8_SB(1, 0), cB + kstep, voffB); PG8_STAGE(PG8_SA(1, 0), cA + kstep, voffA); PG8_STAGE(PG8_SB(1, 1), cB + hstep + kstep, voffB);
        PG8_WAIT_V(6); PG8_BAR;
    } else {
        PG8_STAGE(PG8_SB(0, 0), cB, voffB); PG8_STAGE(PG8_SA(0, 0), cA, voffA); PG8_STAGE(PG8_SB(0, 1), cB + hstep, voffB); PG8_STAGE(PG8_SA(0, 1), cA + hstep, voffA);
        if (wr == 1) PG8_BAR;
        PG8_WAIT_V(4); PG8_BAR;
        PG8_STAGE(PG8_SB(1, 0), cB + kstep, voffB); PG8_STAGE(PG8_SA(1, 0), cA + kstep, voffA); PG8_STAGE(PG8_SB(1, 1), cB + hstep + kstep, voffB);
        PG8_WAIT_V(6); PG8_BAR;
    }
    for (;;) {
        const bool has_next = S.next(ui + 1, nxt);
        const char* nA = has_next ? (const char*)g.A + (size_t)nxt.pm * tstep : cA; const char* nB = has_next ? (const char*)g.Bt + (size_t)nxt.pn * tstep : cB;
        for (int t = 0; t < nt; t += 2) {
            const bool last = (t == nt - 2);
            const char* a1 = cA + (size_t)(t + 1) * kstep;
            const char* a2 = last ? nA : cA + (size_t)(t + 2) * kstep; const char* b2 = last ? nB : cB + (size_t)(t + 2) * kstep;
            const char* a3 = a2 + kstep; const char* b3 = b2 + kstep;
            if (last && has_next) S.a_ready(nxt, ui + 1);
            if constexpr (SP2) {
            PG8_LDB(B0, 0, 0); PG8_LDB(B1, 0, 1); PG8_SCHED; PG8_LDA(At, 0, 0); PG8_STAGE(PG8_SA(1, 1), a1 + hstep, voffA);
            PG8_WAIT_V(8); PG8_WAIT_L(0); PG8_BAR; PG8_MMA(0, 0, At, B0); PG8_MMA(0, 1, At, B1); PG8_BAR; PG8_SCHED;
            PG8_LDA(At, 0, 1); PG8_STAGE(PG8_SB(0, 0), b2, voffB); PG8_STAGE(PG8_SB(0, 1), b2 + hstep, voffB); PG8_STAGE(PG8_SA(0, 0), a2, voffA);
            PG8_WAIT_V(8); PG8_WAIT_L(0); PG8_BAR; PG8_MMA(1, 0, At, B0); PG8_MMA(1, 1, At, B1); PG8_BAR; PG8_SCHED;
            PG8_LDB(B0, 1, 0); PG8_LDB(B1, 1, 1); PG8_SCHED; PG8_LDA(At, 1, 0); PG8_STAGE(PG8_SA(0, 1), a2 + hstep, voffA);
            PG8_WAIT_V(8); PG8_WAIT_L(0); PG8_BAR; PG8_MMA(0, 0, At, B0); PG8_MMA(0, 1, At, B1); PG8_BAR; PG8_SCHED;
            PG8_LDA(At, 1, 1); PG8_STAGE(PG8_SB(1, 0), b3, voffB); PG8_STAGE(PG8_SB(1, 1), b3 + hstep, voffB); PG8_STAGE(PG8_SA(1, 0), a3, voffA);
            PG8_WAIT_V(8); PG8_WAIT_L(0); PG8_BAR; PG8_MMA(1, 0, At, B0); PG8_MMA(1, 1, At, B1); PG8_BAR; PG8_SCHED;
            } else {
            PG8_LDB(B0, 0, 0); PG8_SCHED; PG8_LDA(At, 0, 0); PG8_STAGE(PG8_SA(1, 1), a1 + hstep, voffA);
            PG8_WAIT_L(8); PG8_BAR; PG8_WAIT_L(0); PG8_MMA(0, 0, At, B0); PG8_BAR; PG8_SCHED;
            PG8_LDB(B1, 0, 1); PG8_STAGE(PG8_SB(0, 0), b2, voffB);
            PG8_BAR; PG8_WAIT_L(0); PG8_MMA(0, 1, At, B1); PG8_BAR;
            PG8_LDA(At, 0, 1); PG8_STAGE(PG8_SA(0, 0), a2, voffA);
            PG8_BAR; PG8_WAIT_L(0); PG8_MMA(1, 0, At, B0); PG8_BAR; PG8_SCHED;
            PG8_STAGE(PG8_SB(0, 1), b2 + hstep, voffB);
            PG8_WAIT_V(6); PG8_BAR; PG8_MMA(1, 1, At, B1); PG8_BAR;
            PG8_LDB(B0, 1, 0); PG8_SCHED; PG8_LDA(At, 1, 0); PG8_STAGE(PG8_SA(0, 1), a2 + hstep, voffA);
            PG8_WAIT_L(8); PG8_BAR; PG8_WAIT_L(0); PG8_MMA(0, 0, At, B0); PG8_BAR; PG8_SCHED;
            PG8_LDB(B1, 1, 1); PG8_STAGE(PG8_SB(1, 0), b3, voffB);
            PG8_BAR; PG8_WAIT_L(0); PG8_MMA(0, 1, At, B1); PG8_BAR;
            PG8_LDA(At, 1, 1); PG8_STAGE(PG8_SA(1, 0), a3, voffA);
            PG8_BAR; PG8_WAIT_L(0); PG8_MMA(1, 0, At, B0); PG8_BAR; PG8_SCHED;
            PG8_STAGE(PG8_SB(1, 1), b3 + hstep, voffB);
            PG8_WAIT_V(6); PG8_BAR; PG8_MMA(1, 1, At, B1); PG8_BAR;
            }
        }
        if constexpr (ALIGN_EPI) { if (wr == 0) PG8_BAR; }
        if constexpr (!Epi::AFTER_DRAIN) { E(acc, cur, wr, wc, fr, fq, ui); S.done(cur); }
        if (!has_next) break;
#pragma unroll
        for (int a = 0; a < 2; ++a)
#pragma unroll
            for (int b = 0; b < 2; ++b)
#pragma unroll
                for (int m = 0; m < 4; ++m)
#pragma unroll
                    for (int n = 0; n < 2; ++n) acc[a][b][m][n] = (f32x4){0.f, 0.f, 0.f, 0.f};
        cur = nxt; cA = nA; cB = nB; ++ui;
        if constexpr (ALIGN_EPI) { if (wr == 1) PG8_BAR; }
    }
    PG8_WAIT_V(0);
    if constexpr (!ALIGN_EPI) { if (wr == 0) PG8_BAR; }
    PG8_BAR;
    if constexpr (Epi::AFTER_DRAIN) { E.fused(acc, cur, wr, wc, fr, fq, lds, wid, lane); S.done(cur); }
#undef PG8_SA
#undef PG8_SB
#undef PG8_STAGE
#undef PG8_LDA
#undef PG8_LDB
#undef PG8_MMA
#undef PG8_WAIT_V
#undef PG8_WAIT_L
#undef PG8_BAR
#undef PG8_SCHED
}
}

constexpr int BATCH = 4, SEQ = 8192, DM = 1024, DEPTH = 2, M_TOK = BATCH * SEQ;
constexpr int FF = 2816, NFF = 2 * FF, NMIX = 3072;
constexpr int PW = 2048 + 64;
constexpr int LDT = M_TOK + 64;
constexpr int P_CV = 0, P_QSB = 256, P_KSB = 768, P_QR = 1280, P_KR = 1536, P_GR = 1792;
constexpr int T_VSB = 0, T_VR = 512, T_KR = 768;
constexpr int Y_CV = 0, Y_SB = 256, Y_R = 768;
constexpr int GC = 4, NG = (SEQ / 64) / GC;
constexpr int NWAVES = 8, NTHR = NWAVES * 64;
constexpr int SB_PART1 = 0;
constexpr int LDS_BYTES = 147456;

constexpr size_t MiB = 1u << 20;
constexpr size_t WS_CTL = 0, CTL_BYTES = 65536;
constexpr size_t WS_W = 1 * MiB, W_STRIDE = 42 * MiB;
constexpr size_t WO_1I = 0, WO_1O = 11 * MiB, WO_MN = 33 * MiB / 2, WO_MT = 21 * MiB, WO_MO = 23 * MiB, WO_2I = 25 * MiB, WO_2O = 36 * MiB;
constexpr size_t WS_ROT = 85 * MiB;
constexpr size_t WS_SS = 89 * MiB;
constexpr size_t WS_G = 91 * MiB;
constexpr size_t WS_XB = 100 * MiB, WS_Y = 164 * MiB, WS_T = 228 * MiB, WS_H = 293 * MiB, WS_SP = 469 * MiB, WS_END = 477 * MiB;

#define LAS __attribute__((address_space(3)))
#define DI __device__ __forceinline__
typedef unsigned short bf16_t;
typedef __bf16 bfx8 __attribute__((ext_vector_type(8)));
typedef float f32x16 __attribute__((ext_vector_type(16)));
typedef float f32x4 __attribute__((ext_vector_type(4)));
typedef unsigned u32x4 __attribute__((ext_vector_type(4)));
typedef unsigned u32x2 __attribute__((ext_vector_type(2)));
#define MFMA32(a, b, c) __builtin_amdgcn_mfma_f32_32x32x16_bf16((a), (b), (c), 0, 0, 0)
#define EXP2(x) __builtin_amdgcn_exp2f(x)
#define LOG2(x) __builtin_amdgcn_logf(x)
using pg8::pk2;

DI int crow(int reg, int h) { return (reg & 3) + 8 * (reg >> 2) + 4 * h; }
DI f32x16 zero16() { f32x16 z;
#pragma unroll
    for (int i = 0; i < 16; ++i) z[i] = 0.f; return z; }
template <int S> DI bfx8 pack8(const f32x16& x) {
    u32x4 p; p.x = pk2(x[8 * S], x[8 * S + 1]); p.y = pk2(x[8 * S + 2], x[8 * S + 3]); p.z = pk2(x[8 * S + 4], x[8 * S + 5]); p.w = pk2(x[8 * S + 6], x[8 * S + 7]);
    return __builtin_bit_cast(bfx8, p);
}
DI bfx8 ld8(const bf16_t* p) { return *(const bfx8*)p; }
DI bfx8 ld44(const bf16_t* p) { u32x4 v; const u32x2 a = *(const u32x2*)p, b = *(const u32x2*)(p + 8); v.x = a.x; v.y = a.y; v.z = b.x; v.w = b.y; return __builtin_bit_cast(bfx8, v); }
DI bfx8 lds44(const LAS unsigned char* img, int row, int x, int hi) { const int sw = (row >> 1) & 7; u32x4 v; const u32x2 a = *(const LAS u32x2*)(img + row * 128 + (((2 * x) ^ sw) << 4) + 8 * hi), b = *(const LAS u32x2*)(img + row * 128 + (((2 * x + 1) ^ sw) << 4) + 8 * hi); v.x = a.x; v.y = a.y; v.z = b.x; v.w = b.y; return __builtin_bit_cast(bfx8, v); }
DI float bf_lo(unsigned u) { return __uint_as_float(u << 16); }
DI float bf_hi(unsigned u) { return __uint_as_float(u & 0xffff0000u); }
DI float wave_sum(float v) {
#pragma unroll
    for (int o = 1; o < 64; o <<= 1) v += __shfl_xor(v, o);
    return v;
}
DI float lgamma2(int h) { return (h == 0) ? -0.04580368961312479f : (h == 1) ? -0.02272007650008353f : (h == 2) ? -0.011315313227834146f : -0.005646563141142063f; }

#define SB_TILE(QF, O0, O1, RR, TQ) do { \
        f32x16 s0 = zero16(), s1 = zero16(); \
        _Pragma("unroll") for (int kk = 0; kk < 4; ++kk) { \
            const bfx8 k0 = *(const LAS bfx8*)(kl0 + (((2 * kk + hi) ^ ksw) << 4)), k1 = *(const LAS bfx8*)(kl0 + 4096 + (((2 * kk + hi) ^ ksw) << 4)); \
            s0 = MFMA32(k0, QF[kk], s0); s1 = MFMA32(k1, QF[kk], s1); } \
        bfx8 v00, v01, v02, v03, v10, v11, v12, v13;          \
        { v00 = *(const LAS bfx8*)(vl0 + (((2 * hi) ^ vsw) << 4)); v01 = *(const LAS bfx8*)(vl0 + (((2 * hi + 1) ^ vsw) << 4)); v02 = *(const LAS bfx8*)(vl0 + (((4 + 2 * hi) ^ vsw) << 4)); v03 = *(const LAS bfx8*)(vl0 + (((5 + 2 * hi) ^ vsw) << 4)); \
          v10 = *(const LAS bfx8*)(vl0 + 4096 + (((2 * hi) ^ vsw) << 4)); v11 = *(const LAS bfx8*)(vl0 + 4096 + (((2 * hi + 1) ^ vsw) << 4)); v12 = *(const LAS bfx8*)(vl0 + 4096 + (((4 + 2 * hi) ^ vsw) << 4)); v13 = *(const LAS bfx8*)(vl0 + 4096 + (((5 + 2 * hi) ^ vsw) << 4)); } \
          \
        _Pragma("unroll") for (int i = 0; i < 16; ++i) { \
            { float om = __builtin_amdgcn_rcpf(1.0f + EXP2(fminf(s0[i] * ZC, 64.0f))); \
              if (diag) om = ((key0 + i) < (TQ)) ? om : 1.0f; \
              s0[i] = om; } \
            { float om = __builtin_amdgcn_rcpf(1.0f + EXP2(fminf(s1[i] * ZC, 64.0f))); \
              if (diag) om = ((key0 + 32 + i) < (TQ)) ? om : 1.0f; \
              s1[i] = om; } } \
        const float m0 = (((s0[0] * s0[1]) * (s0[2] * s0[3])) * ((s0[4] * s0[5]) * (s0[6] * s0[7]))) * (((s0[8] * s0[9]) * (s0[10] * s0[11])) * ((s0[12] * s0[13]) * (s0[14] * s0[15]))); \
        const float m1 = (((s1[0] * s1[1]) * (s1[2] * s1[3])) * ((s1[4] * s1[5]) * (s1[6] * s1[7]))) * (((s1[8] * s1[9]) * (s1[10] * s1[11])) * ((s1[12] * s1[13]) * (s1[14] * s1[15]))); \
        const float x0 = __shfl_xor(m0, 32), x1 = __shfl_xor(m1, 32);     \
        const float c1 = (hi == 0) ? RR * x1 : RR;            \
        const float base = RR * (m1 * x1); \
        const float c0 = (hi == 0) ? base * x0 : base; \
        RR = base * (m0 * x0); \
        { float t = c1; _Pragma("unroll") for (int i = 15; i >= 0; --i) { const float l = s1[i]; s1[i] = __builtin_fmaf(-l, t, t); t *= l; } } \
        { float t = c0; _Pragma("unroll") for (int i = 15; i >= 0; --i) { const float l = s0[i]; s0[i] = __builtin_fmaf(-l, t, t); t *= l; } } \
        { const bfx8 w = pack8<0>(s0); O0 = MFMA32(v00, w, O0); O1 = MFMA32(v10, w, O1); } \
        { const bfx8 w = pack8<1>(s0); O0 = MFMA32(v01, w, O0); O1 = MFMA32(v11, w, O1); } \
        { const bfx8 w = pack8<0>(s1); O0 = MFMA32(v02, w, O0); O1 = MFMA32(v12, w, O1); } \
        { const bfx8 w = pack8<1>(s1); O0 = MFMA32(v03, w, O0); O1 = MFMA32(v13, w, O1); } } while (0)

DI void sb_unit(int item, const bf16_t* __restrict__ P, const bf16_t* __restrict__ T, bf16_t* __restrict__ Y, int lane, LAS unsigned char* wl) {
    const int qp2 = item & 127, bh = item >> 7, b = bh >> 3, h = bh & 7;
    const int n = lane & 31, hi = lane >> 5;
    const int t0 = qp2 * 64, tqa = t0 + n, tqb = t0 + 32 + n;
    const size_t tokb = (size_t)b * SEQ;
    bfx8 qa[4], qb[4];
    {
        const int srow_ = lane >> 3, sch_ = lane & 7;
        const bf16_t* qg = P + (tokb + t0 + srow_) * PW + P_QSB + h * 64 + 8 * sch_;
        u32x4 qr[8];
#pragma unroll
        for (int i = 0; i < 8; ++i) qr[i] = *(const u32x4*)(qg + (size_t)(8 * i) * PW);
#pragma unroll
        for (int i = 0; i < 8; ++i) { const int r = 8 * i + srow_; *(LAS u32x4*)(wl + r * 128 + ((sch_ ^ ((r >> 1) & 7)) << 4)) = qr[i]; }
#pragma unroll
        for (int kk = 0; kk < 4; ++kk) { qa[kk] = *(const LAS bfx8*)(wl + n * 128 + (((2 * kk + hi) ^ ((n >> 1) & 7)) << 4)); qb[kk] = *(const LAS bfx8*)(wl + (32 + n) * 128 + (((2 * kk + hi) ^ ((n >> 1) & 7)) << 4)); }
    }
    f32x16 oa0 = zero16(), oa1 = zero16(), ob0 = zero16(), ob1 = zero16(); float Ra = 1.0f, Rb = 1.0f;
    const int kmap = 16 * ((n >> 2) & 1) + 4 * (n >> 3) + (n & 3);
    const int srow = lane >> 3, sch = lane & 7;
    const bf16_t* kg = P + (tokb + srow) * PW + P_KSB + h * 64 + 8 * sch;
    const bf16_t* vg = T + (size_t)(T_VSB + h * 64 + srow) * LDT + tokb + 8 * sch;
    const LAS unsigned char* kl0 = wl + kmap * 128; const int ksw = (kmap >> 1) & 7;
    const LAS unsigned char* vl0 = wl + 8192 + n * 128; const int vsw = (n >> 1) & 7;
    const int kd = t0 >> 6;
    const float ZC = 0.18033688011112042f;
    bool livea = true, liveb = true;
    for (int kt = kd; kt >= 0; --kt) {
        const int kbase = kt * 64;
        { u32x4 kr[8], vr[8];
#pragma unroll
          for (int i = 0; i < 8; ++i) { kr[i] = *(const u32x4*)(kg + (size_t)(kbase + 8 * i) * PW); vr[i] = *(const u32x4*)(vg + (size_t)(8 * i) * LDT + kbase); }
#pragma unroll
          for (int i = 0; i < 8; ++i) { const int r = 8 * i + srow; const int off = r * 128 + ((sch ^ ((r >> 1) & 7)) << 4);
              *(LAS u32x4*)(wl + off) = kr[i]; *(LAS u32x4*)(wl + 8192 + off) = vr[i]; } }
        const bool diag = (kt == kd);
        const int key0 = kbase + 16 * hi;
        if (livea) { SB_TILE(qa, oa0, oa1, Ra, tqa); livea = __builtin_amdgcn_ballot_w64(Ra > 1e-36f) != 0ull; }
        if (liveb) { SB_TILE(qb, ob0, ob1, Rb, tqb); liveb = __builtin_amdgcn_ballot_w64(Rb > 1e-36f) != 0ull; }
        if (!livea && !liveb) break;
    }
    {
#pragma unroll
        for (int g = 0; g < 4; ++g) {
            const int ra = n, rb = 32 + n;
            u32x2 w; w.x = pk2(oa0[4 * g], oa0[4 * g + 1]); w.y = pk2(oa0[4 * g + 2], oa0[4 * g + 3]); *(LAS u32x2*)(wl + ra * 128 + (((g) ^ ((ra >> 1) & 7)) << 4) + 8 * hi) = w;
            u32x2 w2; w2.x = pk2(oa1[4 * g], oa1[4 * g + 1]); w2.y = pk2(oa1[4 * g + 2], oa1[4 * g + 3]); *(LAS u32x2*)(wl + ra * 128 + (((4 + g) ^ ((ra >> 1) & 7)) << 4) + 8 * hi) = w2;
            u32x2 w3; w3.x = pk2(ob0[4 * g], ob0[4 * g + 1]); w3.y = pk2(ob0[4 * g + 2], ob0[4 * g + 3]); *(LAS u32x2*)(wl + rb * 128 + (((g) ^ ((rb >> 1) & 7)) << 4) + 8 * hi) = w3;
            u32x2 w4; w4.x = pk2(ob1[4 * g], ob1[4 * g + 1]); w4.y = pk2(ob1[4 * g + 2], ob1[4 * g + 3]); *(LAS u32x2*)(wl + rb * 128 + (((4 + g) ^ ((rb >> 1) & 7)) << 4) + 8 * hi) = w4;
        }
        bf16_t* yg = Y + (tokb + t0 + srow) * DM + Y_SB + h * 64 + 8 * sch;
#pragma unroll
        for (int i = 0; i < 8; ++i) { const int r = 8 * i + srow; *(u32x4*)(yg + (size_t)(8 * i) * DM) = *(const LAS u32x4*)(wl + r * 128 + ((sch ^ ((r >> 1) & 7)) << 4)); }
    }
}

DI void conv_unit(int item, const bf16_t* __restrict__ P, bf16_t* __restrict__ Y, const float* __restrict__ cw, const float* __restrict__ cb,
                  const float* __restrict__ lng, const float* __restrict__ lnb, int lane) {
    const int tok0 = item * 16;
    f32x4 w[31];
#pragma unroll
    for (int j = 0; j < 31; ++j) w[j] = *(const f32x4*)(cw + j * 256 + 4 * lane);
    const f32x4 bias = *(const f32x4*)(cb + 4 * lane), g4 = *(const f32x4*)(lng + 4 * lane), b4 = *(const f32x4*)(lnb + 4 * lane);
#pragma unroll 1
    for (int ps = 0; ps < 4; ++ps) {
        const int tok = tok0 + 4 * ps, tl = tok & (SEQ - 1);
        const bf16_t* src = P + (size_t)tok * PW + P_CV + 4 * lane;
        u32x2 r[34];
#pragma unroll
        for (int i = 0; i < 34; ++i) { const bool ok = (tl - 30 + i) >= 0; const u32x2 v = *(const u32x2*)(src + (ok ? (i - 30) * PW : 0)); r[i].x = ok ? v.x : 0u; r[i].y = ok ? v.y : 0u; }
        f32x4 acc[4];
#pragma unroll
        for (int tt = 0; tt < 4; ++tt) { acc[tt] = bias;
#pragma unroll
            for (int j = 0; j < 31; ++j) { const u32x2 v = r[tt + j]; f32x4 x; x[0] = bf_lo(v.x); x[1] = bf_hi(v.x); x[2] = bf_lo(v.y); x[3] = bf_hi(v.y); acc[tt] += w[j] * x; } }
        float mean[4], var[4];
#pragma unroll
        for (int tt = 0; tt < 4; ++tt) mean[tt] = (acc[tt][0] + acc[tt][1]) + (acc[tt][2] + acc[tt][3]);
#pragma unroll
        for (int o = 1; o < 64; o <<= 1) {
#pragma unroll
            for (int tt = 0; tt < 4; ++tt) mean[tt] += __shfl_xor(mean[tt], o); }
#pragma unroll
        for (int tt = 0; tt < 4; ++tt) { mean[tt] *= (1.0f / 256.0f); acc[tt] -= mean[tt]; var[tt] = (acc[tt][0] * acc[tt][0] + acc[tt][1] * acc[tt][1]) + (acc[tt][2] * acc[tt][2] + acc[tt][3] * acc[tt][3]); }
#pragma unroll
        for (int o = 1; o < 64; o <<= 1) {
#pragma unroll
            for (int tt = 0; tt < 4; ++tt) var[tt] += __shfl_xor(var[tt], o); }
#pragma unroll
        for (int tt = 0; tt < 4; ++tt) {
            const float rs = 1.0f / sqrtf(var[tt] * (1.0f / 256.0f) + 1e-6f);
            const f32x4 y = pg8::silu4(acc[tt] * rs * g4 + b4);
            u32x2 o; o.x = pk2(y[0], y[1]); o.y = pk2(y[2], y[3]);
            *(u32x2*)(Y + (size_t)(tok + tt) * DM + Y_CV + 4 * lane) = o;
        }
    }
}

#define RET_STAGE(img_, gbase_, pitch_) do { \
    u32x4 r_[8]; \
    _Pragma("unroll") for (int i_ = 0; i_ < 8; ++i_) r_[i_] = *(const u32x4*)((gbase_) + (size_t)(8 * i_ + (lane >> 3)) * (pitch_) + 8 * (lane & 7)); \
    _Pragma("unroll") for (int i_ = 0; i_ < 8; ++i_) { const int rr_ = 8 * i_ + (lane >> 3); *(LAS u32x4*)((img_) + rr_ * 128 + (((lane & 7) ^ ((rr_ >> 1) & 7)) << 4)) = r_[i_]; } } while (0)
#define RET_STAGE_LOAD(r_, n_, gbase_, pitch_) do { _Pragma("unroll") for (int i_ = 0; i_ < (n_); ++i_) r_[i_] = *(const u32x4*)((gbase_) + (size_t)(8 * i_ + (lane >> 3)) * (pitch_) + 8 * (lane & 7)); } while (0)
#define RET_STAGE_STORE(img_, r_, n_) do { _Pragma("unroll") for (int i_ = 0; i_ < (n_); ++i_) { const int rr_ = 8 * i_ + (lane >> 3); *(LAS u32x4*)((img_) + rr_ * 128 + (((lane & 7) ^ ((rr_ >> 1) & 7)) << 4)) = r_[i_]; } } while (0)
#define RET_FRAG(img_, row_, chunk_) (*(const LAS bfx8*)((img_) + (row_) * 128 + (((chunk_) ^ (((row_) >> 1) & 7)) << 4)))
#define RET_UPDATE(kimg_, vimg_) do { \
    _Pragma("unroll") for (int js = 0; js < 4; ++js) { \
        const bfx8 a0_ = RET_FRAG(kimg_, n, 2 * js + hi), a1_ = RET_FRAG(kimg_, 32 + n, 2 * js + hi), b0_ = RET_FRAG(vimg_, n, 2 * js + hi), b1_ = RET_FRAG(vimg_, 32 + n, 2 * js + hi); \
        st00 = MFMA32(a0_, b0_, st00); st01 = MFMA32(a0_, b1_, st01); st10 = MFMA32(a1_, b0_, st10); st11 = MFMA32(a1_, b1_, st11); } } while (0)

DI void ret1_unit(int item, const bf16_t* __restrict__ T, float* __restrict__ G, int lane, LAS unsigned char* wl) {
    const int g = item % NG, bh = item / NG, b = bh >> 2, h = bh & 3;
    const int n = lane & 31, hi = lane >> 5;
    const float cd = EXP2(lgamma2(h) * 64.0f);
    f32x16 st00 = zero16(), st01 = zero16(), st10 = zero16(), st11 = zero16();
    for (int c = 0; c < GC; ++c) {
        const size_t tb = (size_t)b * SEQ + (size_t)(g * GC + c) * 64;
        if (c > 0) { st00 *= cd; st01 *= cd; st10 *= cd; st11 *= cd; }
        RET_STAGE(wl, T + (size_t)(T_KR + h * 64) * LDT + tb, LDT); RET_STAGE(wl + 8192, T + (size_t)(T_VR + h * 64) * LDT + tb, LDT);
        RET_UPDATE(wl, wl + 8192);
    }
    f32x4* gp = (f32x4*)(G + (size_t)item * 4096) + lane * 4;
#pragma unroll
    for (int q = 0; q < 4; ++q) {
        gp[q] = (f32x4){st00[4 * q], st00[4 * q + 1], st00[4 * q + 2], st00[4 * q + 3]}; gp[256 + q] = (f32x4){st01[4 * q], st01[4 * q + 1], st01[4 * q + 2], st01[4 * q + 3]};
        gp[512 + q] = (f32x4){st10[4 * q], st10[4 * q + 1], st10[4 * q + 2], st10[4 * q + 3]}; gp[768 + q] = (f32x4){st11[4 * q], st11[4 * q + 1], st11[4 * q + 2], st11[4 * q + 3]}; }
}

template <int PREFIX_ONLY> DI void ret2_unit(int item2, const bf16_t* __restrict__ P, const bf16_t* __restrict__ T, const float* __restrict__ G, bf16_t* __restrict__ Y,
                  const float* __restrict__ gain, int lane, LAS unsigned char* wl) {
    const int it = item2 & 1, item = item2 >> 1;
    const int g = item % NG, bh = item / NG, b = bh >> 2, h = bh & 3;
    const unsigned n0_ = lane & 31, hi0_ = lane >> 5;
    const float lg = lgamma2(h);
    const float cd = EXP2(lg * 64.0f), cdG = EXP2(lg * (64.0f * GC));
    f32x16 st00 = zero16(), st01 = zero16(), st10 = zero16(), st11 = zero16();
    if (g > 0) {
        const f32x4* sp = (const f32x4*)(G + (size_t)(bh * NG + g) * 4096) + lane * 4;
#pragma unroll
        for (int q = 0; q < 4; ++q) { const f32x4 a0 = sp[q], a1 = sp[256 + q], a2 = sp[512 + q], a3 = sp[768 + q];
#pragma unroll
            for (int e = 0; e < 4; ++e) { st00[4 * q + e] = a0[e]; st01[4 * q + e] = a1[e]; st10[4 * q + e] = a2[e]; st11[4 * q + e] = a3[e]; } }
    }
    if (PREFIX_ONLY == 1) { if (st00[0] + st01[1] + st10[2] + st11[3] == 12345.678f) Y[0] = 0; return; }
    const float* gn = gain + h * 64;
#pragma unroll 1
    for (int c = 0; c < (PREFIX_ONLY == 2 ? 1 : GC); ++c) {
        const size_t tb = (size_t)b * SEQ + (size_t)(g * GC + c) * 64;
        const bf16_t* Pq = P + tb * PW + P_QR + h * 64; const bf16_t* Pk = P + tb * PW + P_KR + h * 64; const bf16_t* Pg = P + tb * PW + P_GR + h * 64;
        bf16_t* Yb = Y + tb * DM + Y_R + h * 64; const bf16_t* Tv = T + (size_t)(T_VR + h * 64) * LDT + tb;
        RET_STAGE(wl, Pk, PW); RET_STAGE(wl + 8192, Tv, LDT);
        u32x4 gr[4], ktr[8];
        RET_STAGE_LOAD(gr, 4, Pg + (size_t)(32 * it) * PW, PW);
        if (c + 1 < GC) RET_STAGE_LOAD(ktr, 8, T + (size_t)(T_KR + h * 64) * LDT + tb, LDT);
        {
            unsigned n = n0_, hi = hi0_; asm volatile("" : "+v"(n), "+v"(hi));
            const unsigned ov = n * (unsigned)LDT + 4u * hi;
            const unsigned il = 32u * it + n, oq = il * PW;
            f32x16 y0 = zero16(), y1 = zero16();
            { const bfx8 q0 = ld44(Pq + (oq + 4 * hi)), q1 = ld44(Pq + (oq + 16 + 4 * hi)), q2 = ld44(Pq + (oq + 32 + 4 * hi)), q3 = ld44(Pq + (oq + 48 + 4 * hi));
              y0 = MFMA32(pack8<0>(st00), q0, y0); y1 = MFMA32(pack8<0>(st01), q0, y1);
              y0 = MFMA32(pack8<1>(st00), q1, y0); y1 = MFMA32(pack8<1>(st01), q1, y1);
              y0 = MFMA32(pack8<0>(st10), q2, y0); y1 = MFMA32(pack8<0>(st11), q2, y1);
              y0 = MFMA32(pack8<1>(st10), q3, y0); y1 = MFMA32(pack8<1>(st11), q3, y1); }

            const float qdec = EXP2(lg * (float)(il + 1));
            y0 *= qdec; y1 *= qdec;
            f32x16 sc0 = zero16(), sc1 = zero16();
            { const unsigned ok = n * PW + 8 * hi;
#pragma unroll
              for (int kk = 0; kk < 4; ++kk) { const bfx8 qn = ld8(Pq + (oq + 16 * kk + 8 * hi)); const bfx8 k0 = RET_FRAG(wl, n, 2 * kk + hi), k1 = RET_FRAG(wl, 32 + n, 2 * kk + hi);
                  sc0 = MFMA32(k0, qn, sc0); sc1 = MFMA32(k1, qn, sc1);  } }

#pragma unroll
            for (int i = 0; i < 16; ++i) { const int j0 = crow(i, hi); sc0[i] *= EXP2(lg * fabsf((float)((int)il - j0))); sc1[i] *= EXP2(lg * fabsf((float)((int)il - j0 - 32))); }
            { const LAS unsigned char* vimg = wl + 8192;
              { const bfx8 w = pack8<0>(sc0); y0 = MFMA32(lds44(vimg, n, 0, hi), w, y0); y1 = MFMA32(lds44(vimg, 32 + n, 0, hi), w, y1); }
              { const bfx8 w = pack8<1>(sc0); y0 = MFMA32(lds44(vimg, n, 1, hi), w, y0); y1 = MFMA32(lds44(vimg, 32 + n, 1, hi), w, y1); }
              { const bfx8 w = pack8<0>(sc1); y0 = MFMA32(lds44(vimg, n, 2, hi), w, y0); y1 = MFMA32(lds44(vimg, 32 + n, 2, hi), w, y1); }
              { const bfx8 w = pack8<1>(sc1); y0 = MFMA32(lds44(vimg, n, 3, hi), w, y0); y1 = MFMA32(lds44(vimg, 32 + n, 3, hi), w, y1); } }
            float sum = 0.f;
#pragma unroll
            for (int i = 0; i < 16; ++i) sum += y0[i] + y1[i];
            sum += __shfl_xor(sum, 32);
            const float mean = sum * (1.0f / 64.0f);
            float sq = 0.f;
#pragma unroll
            for (int i = 0; i < 16; ++i) { y0[i] -= mean; y1[i] -= mean; sq += y0[i] * y0[i] + y1[i] * y1[i]; }
            sq += __shfl_xor(sq, 32);
            const float rs = 1.0f / sqrtf(sq * (1.0f / 64.0f) + 1e-6f);
            { const int srow = lane >> 3, sch = lane & 7;
              RET_STAGE_STORE(wl, gr, 4);
#pragma unroll
              for (int q = 0; q < 4; ++q) {
                { const u32x2 gv = *(const LAS u32x2*)(wl + n * 128 + (((q) ^ ((n >> 1) & 7)) << 4) + 8 * hi); const f32x4 gg = *(const f32x4*)(gn + (4 * hi + 8 * q));
                  const float g0 = bf_lo(gv.x), g1 = bf_hi(gv.x), g2 = bf_lo(gv.y), g3 = bf_hi(gv.y);
                  u32x2 o; o.x = pk2(y0[4 * q] * rs * gg[0] * (g0 * pg8::sigmoid_f(g0)), y0[4 * q + 1] * rs * gg[1] * (g1 * pg8::sigmoid_f(g1)));
                  o.y = pk2(y0[4 * q + 2] * rs * gg[2] * (g2 * pg8::sigmoid_f(g2)), y0[4 * q + 3] * rs * gg[3] * (g3 * pg8::sigmoid_f(g3)));
                  *(LAS u32x2*)(wl + 4096 + n * 128 + (((q) ^ ((n >> 1) & 7)) << 4) + 8 * hi) = o; }
                { const u32x2 gv = *(const LAS u32x2*)(wl + n * 128 + (((4 + q) ^ ((n >> 1) & 7)) << 4) + 8 * hi); const f32x4 gg = *(const f32x4*)(gn + (4 * hi + 32 + 8 * q));
                  const float g0 = bf_lo(gv.x), g1 = bf_hi(gv.x), g2 = bf_lo(gv.y), g3 = bf_hi(gv.y);
                  u32x2 o; o.x = pk2(y1[4 * q] * rs * gg[0] * (g0 * pg8::sigmoid_f(g0)), y1[4 * q + 1] * rs * gg[1] * (g1 * pg8::sigmoid_f(g1)));
                  o.y = pk2(y1[4 * q + 2] * rs * gg[2] * (g2 * pg8::sigmoid_f(g2)), y1[4 * q + 3] * rs * gg[3] * (g3 * pg8::sigmoid_f(g3)));
                  *(LAS u32x2*)(wl + 4096 + n * 128 + (((4 + q) ^ ((n >> 1) & 7)) << 4) + 8 * hi) = o; }
              }
              bf16_t* yg = Yb + (size_t)(32 * it + srow) * DM + 8 * sch;
#pragma unroll
              for (int i = 0; i < 4; ++i) { const int r = 8 * i + srow; *(u32x4*)(yg + (size_t)(8 * i) * DM) = *(const LAS u32x4*)(wl + 4096 + r * 128 + ((sch ^ ((r >> 1) & 7)) << 4)); }
            }
        }
        if (c + 1 < GC) { unsigned n = n0_, hi = hi0_; asm volatile("" : "+v"(n), "+v"(hi)); st00 *= cd; st01 *= cd; st10 *= cd; st11 *= cd;
            RET_STAGE_STORE(wl, ktr, 8); RET_UPDATE(wl, wl + 8192); }
    }
}

struct TrItem { const float* src; const float* gain; bf16_t* dst; int N, K, k0, drow0; };
DI void tr_load(const TrItem& t, float (&v)[32], int lane) {
    const float* p = t.src + (size_t)(t.k0 + (lane >> 5)) * t.N + (lane & 31);
#pragma unroll
    for (int i = 0; i < 32; ++i) v[i] = __builtin_nontemporal_load(p + (size_t)(2 * i) * t.N);
}
DI void tr_store(const TrItem& t, const float (&v)[32], LAS float* scr, int lane) {
#pragma unroll
    for (int i = 0; i < 32; ++i) scr[(2 * i + (lane >> 5)) * 33 + (lane & 31)] = v[i];
    asm volatile("s_waitcnt lgkmcnt(0)" ::: "memory");
    const int c = lane & 7;
    f32x4 g0 = {1.f, 1.f, 1.f, 1.f}, g1 = g0;
    if (t.gain) { g0 = *(const f32x4*)(t.gain + t.k0 + 8 * c); g1 = *(const f32x4*)(t.gain + t.k0 + 8 * c + 4); }
#pragma unroll
    for (int j = 0; j < 4; ++j) { const int nn = (lane >> 3) + 8 * j; const LAS float* s = scr + (8 * c) * 33 + nn;
        u32x4 o; o.x = pk2(s[0 * 33] * g0[0], s[1 * 33] * g0[1]); o.y = pk2(s[2 * 33] * g0[2], s[3 * 33] * g0[3]); o.z = pk2(s[4 * 33] * g1[0], s[5 * 33] * g1[1]); o.w = pk2(s[6 * 33] * g1[2], s[7 * 33] * g1[3]);
        *(u32x4*)(t.dst + (size_t)(t.drow0 + nn) * t.K + t.k0 + 8 * c) = o; }
    asm volatile("s_waitcnt lgkmcnt(0)" ::: "memory");
}
DI int srcmap(int type, int n0) {
    const int tile = n0 >> 8, c = n0 & 255, bj = c >> 7, p = c & 127;
    if (type == 0) return bj * FF + 128 * tile + p;
    if (type == 1) return n0;
    if (type == 2) {
        if (tile < 2) return bj * 256 + 128 * tile + p;
        if (tile < 6) return 512 + 256 * (tile - 2) + c;
        if (tile == 6) return 2048 + (p >> 5) * 64 + 32 * bj + (p & 31);
        if (tile == 7) return 2304 + (p >> 5) * 64 + 32 * bj + (p & 31);
        return 2816 + c;
    }
    if (tile < 2) return 1536 + n0;
    if (tile == 2) return 2560 + c;
    return 2304 + (p >> 5) * 64 + 32 * bj + (p & 31);
}

#define XB_TMO      128
#define XB_XCNT(j)  (256  + 64 * (j))
#define XB_XSUB(j)  (1280 + 64 * (j))
#define XB_XGEN(j)  (2304 + 64 * (j))
#define XB_TOP      3328
#define XB_TOPGEN   3392
#define XCD_BAR_WORDS 3456
#define XB_SPIN_CAP (1u << 18)

__device__ __forceinline__ unsigned xb_ld(unsigned* p)              { return __hip_atomic_load(p, __ATOMIC_RELAXED, __HIP_MEMORY_SCOPE_AGENT); }
__device__ __forceinline__ unsigned xb_add(unsigned* p, unsigned v) { return __hip_atomic_fetch_add(p, v, __ATOMIC_RELAXED, __HIP_MEMORY_SCOPE_AGENT); }
__device__ __forceinline__ unsigned xb_xcc_id() { return (unsigned)__builtin_amdgcn_s_getreg((3 << 11) | 20) & 0xFu; }
#define XB_SPIN(cond, bar) do { unsigned _sp = 0; while (cond) { __builtin_amdgcn_s_sleep(1); \
    if ((++_sp & 255u) == 0u) { if (xb_ld(&(bar)[XB_TMO])) break; if (_sp > XB_SPIN_CAP) { atomicAdd(&(bar)[XB_TMO], 1u); break; } } } } while (0)

struct XcdBarrier {
    unsigned* bar; unsigned x;
    volatile LAS unsigned* st;
};

__device__ __forceinline__ XcdBarrier xcd_barrier_post(unsigned* bar, volatile LAS unsigned* st) {
    XcdBarrier b; b.bar = bar; b.x = xb_xcc_id(); b.st = st;
    if (threadIdx.x == 0) (void)xb_add(&bar[XB_XCNT(b.x)], 1u);
    return b;
}
__device__ __forceinline__ void xcd_barrier_complete(unsigned* bar, unsigned x, unsigned& nloc, unsigned& nx) {
    const unsigned G = gridDim.x * gridDim.y * gridDim.z;
    unsigned sum, cnt, mine, sp = 0u;
    for (;;) {
        sum = 0u; cnt = 0u; mine = 0u;
#pragma unroll
        for (unsigned j = 0; j < 16; ++j) { const unsigned c = xb_ld(&bar[XB_XCNT(j)]); sum += c; cnt += (c > 0u) ? 1u : 0u; mine = (j == x) ? c : mine; }
        if (sum == G) break;
        __builtin_amdgcn_s_sleep(1);
        if ((++sp & 255u) == 0u) { if (xb_ld(&bar[XB_TMO])) break; if (sp > XB_SPIN_CAP) { atomicAdd(&bar[XB_TMO], 1u); break; } }
    }
    nloc = mine > 0u ? mine : 1u; nx = cnt > 0u ? cnt : 1u;
}

__device__ __forceinline__ void xcd_barrier(const XcdBarrier& b) {
    asm volatile("s_waitcnt vmcnt(0)" ::: "memory");
    __syncthreads();
    if (threadIdx.x == 0) {
        unsigned* bar = b.bar;
        __builtin_amdgcn_s_waitcnt(0);
        unsigned nloc = b.st[0], nx = b.st[1];
        if (nloc == 0u) { xcd_barrier_complete(bar, b.x, nloc, nx); b.st[0] = nloc; b.st[1] = nx; }
        const unsigned old = xb_add(&bar[XB_XSUB(b.x)], 1u);
        const unsigned gen = old / nloc;
        if (old + 1u == (gen + 1u) * nloc) {
            __builtin_amdgcn_fence(__ATOMIC_RELEASE, "agent");
            asm volatile("s_waitcnt vmcnt(0)" ::: "memory");
            const unsigned og = xb_add(&bar[XB_TOP], 1u);
            const unsigned tg = og / nx;
            if (og + 1u == (tg + 1u) * nx) xb_add(&bar[XB_TOPGEN], 1u);
            else XB_SPIN(xb_ld(&bar[XB_TOPGEN]) == tg, bar);
            __builtin_amdgcn_fence(__ATOMIC_ACQUIRE, "agent");
            xb_add(&bar[XB_XGEN(b.x)], 1u);
            asm volatile("s_waitcnt vmcnt(0)" ::: "memory");
        } else {
            XB_SPIN(xb_ld(&bar[XB_XGEN(b.x)]) == gen, bar);
            __builtin_amdgcn_fence(__ATOMIC_ACQUIRE, "agent");
            asm volatile("s_waitcnt vmcnt(0)" ::: "memory");
        }
    }
    __syncthreads();
}

#ifdef NO_R1
#define DO_R1(...)
#else
#define DO_R1(...) __VA_ARGS__
#endif
#ifdef NO_R2
#define DO_R2(...)
#else
#define DO_R2(...) __VA_ARGS__
#endif
#ifdef NO_SB
#define DO_SB(...)
#else
#define DO_SB(...) __VA_ARGS__
#endif
#ifdef NO_CV
#define DO_CV(...)
#else
#define DO_CV(...) __VA_ARGS__
#endif
#ifdef NO_G0
#define DO_G0(...)
#else
#define DO_G0(...) __VA_ARGS__
#endif
#ifdef NO_G1
#define DO_G1(...)
#else
#define DO_G1(...) __VA_ARGS__
#endif
#ifdef NO_G2
#define DO_G2(...)
#else
#define DO_G2(...) __VA_ARGS__
#endif
#ifdef NO_G3
#define DO_G3(...)
#else
#define DO_G3(...) __VA_ARGS__
#endif

#ifndef P2_PROBE
#define P2_PROBE 3
#endif
#ifndef MI_PROBE
#define MI_PROBE 3
#endif
#ifndef PRO_PART
#define PRO_PART 7
#endif
struct Args { const float* in[16]; float* out; unsigned char* ws; int ph_lo, ph_hi; };
constexpr int PPL = 9, N_PHASES = 2 + PPL * DEPTH;
constexpr int RS_OFF = 131072;

constexpr int RS_SLOTS = 12;
DI void fill_rowscales(const pg8::StaticOrder& S, const float* SS, LAS float* rs, int bycol) {
    pg8::Unit u;
    for (int ui = 0; ui < RS_SLOTS && S.next(ui, u); ++ui) {
        const int t = threadIdx.x;
        if (t < 256) rs[ui * 256 + t] = pg8::rowscale(SS, (bycol ? u.pn : u.pm) * 256 + t);
    }
    __syncthreads();
}

DI TrItem tr_decode(const Args& a, unsigned char* ws, int it) {
    constexpr int I0 = 16 * (NFF / 32), I1 = (FF / 64) * 32, I2 = 16 * 72, I3 = 16 * 32, I4 = 16 * 32, IL = 2 * I0 + 2 * I1 + I2 + I3 + I4;
    const int l = it / IL; int r = it % IL;
    unsigned char* wb = ws + WS_W + (size_t)l * W_STRIDE;
    TrItem t; int type, nblk;
    if (r < I0) { t.src = a.in[2] + (size_t)l * DM * NFF; t.gain = a.in[1] + l * DM; t.dst = (bf16_t*)(wb + WO_1I); t.N = NFF; t.K = DM; type = 0; nblk = NFF / 32; }
    else if ((r -= I0) < I1) { t.src = a.in[3] + (size_t)l * FF * DM; t.gain = nullptr; t.dst = (bf16_t*)(wb + WO_1O); t.N = DM; t.K = FF; type = 1; nblk = 32; }
    else if ((r -= I1) < I2) { t.src = a.in[5] + (size_t)l * DM * NMIX; t.gain = a.in[4] + l * DM; t.dst = (bf16_t*)(wb + WO_MN); t.N = NMIX; t.K = DM; type = 2; nblk = 72; }
    else if ((r -= I2) < I3) { t.src = a.in[5] + (size_t)l * DM * NMIX; t.gain = a.in[4] + l * DM; t.dst = (bf16_t*)(wb + WO_MT); t.N = NMIX; t.K = DM; type = 3; nblk = 32; }
    else if ((r -= I3) < I4) { t.src = a.in[11] + (size_t)l * DM * DM; t.gain = nullptr; t.dst = (bf16_t*)(wb + WO_MO); t.N = DM; t.K = DM; type = 1; nblk = 32; }
    else if ((r -= I4) < I0) { t.src = a.in[13] + (size_t)l * DM * NFF; t.gain = a.in[12] + l * DM; t.dst = (bf16_t*)(wb + WO_2I); t.N = NFF; t.K = DM; type = 0; nblk = NFF / 32; }
    else { r -= I0; t.src = a.in[14] + (size_t)l * FF * DM; t.gain = nullptr; t.dst = (bf16_t*)(wb + WO_2O); t.N = DM; t.K = FF; type = 1; nblk = 32; }
    const int kb = r / nblk, nb = r % nblk;
    t.src += srcmap(type, nb * 32); t.drow0 = nb * 32; t.k0 = kb * 64;
    return t;
}

template <int PH, int REP = 0> DI void run_phase(const Args& a, LAS unsigned char* lds, const int lane, const int wave) {
    const int G = gridDim.x, gw = blockIdx.x * NWAVES + wave, NGW = G * NWAVES;
    unsigned char* ws = a.ws;
    LAS float* rs = (LAS float*)(lds + RS_OFF);
    if constexpr (PH == 0) {
        LAS float* scr = (LAS float*)(lds + wave * 16384);
        constexpr int I0 = 16 * (NFF / 32), I1 = (FF / 64) * 32, I2 = 16 * 72, I3 = 16 * 32, I4 = 16 * 32, IL = 2 * I0 + 2 * I1 + I2 + I3 + I4;
        if (!REP || (PRO_PART & 1)) {
            float va[32], vb[32];
            int it = gw;
            TrItem ta{}, tb{};
            if (it < DEPTH * IL) { ta = tr_decode(a, ws, it); tr_load(ta, va, lane); }
            while (it < DEPTH * IL) {
                const int itb = it + NGW, ita = it + 2 * NGW;
                if (itb < DEPTH * IL) { tb = tr_decode(a, ws, itb); tr_load(tb, vb, lane); }
                tr_store(ta, va, scr, lane);
                if (itb >= DEPTH * IL) break;
                if (ita < DEPTH * IL) { ta = tr_decode(a, ws, ita); tr_load(ta, va, lane); }
                tr_store(tb, vb, scr, lane);
                it = ita;
            }
        }
        { float* SS = (float*)(ws + WS_SS); bf16_t* XB = (bf16_t*)(ws + WS_XB);
          if (!REP || (PRO_PART & 2)) for (int m = gw; m < M_TOK; m += NGW) {
            const f32x4* xr = (const f32x4*)(a.in[0] + (size_t)m * DM) + lane; float s = 0.f;
            unsigned long long* o8 = (unsigned long long*)(XB + (size_t)m * DM) + lane;
#pragma unroll
            for (int j = 0; j < 4; ++j) { const f32x4 v = __builtin_nontemporal_load(xr + 64 * j); s += (v[0] * v[0] + v[1] * v[1]) + (v[2] * v[2] + v[3] * v[3]);
                o8[64 * j] = (unsigned long long)pk2(v[0], v[1]) | ((unsigned long long)pk2(v[2], v[3]) << 32); }
            s = wave_sum(s);
            if (lane < 16) SS[(size_t)m * 16 + lane] = (lane == 0) ? s : 0.f;
          } }
        { float* cosT = (float*)(ws + WS_ROT); float* sinT = cosT + 262144; float* cosTT = sinT + 262144; float* sinTT = cosTT + 262144;
          if (!REP || (PRO_PART & 4)) for (int idx = blockIdx.x * NTHR + threadIdx.x; idx < 262144; idx += G * NTHR) {
            const int pos = idx >> 5, dd = idx & 31;
            double inv = 0.15915494309189535;
            for (int q = 0; q < dd; ++q) inv *= 0.7498942093324558;
            const double rev = (double)pos * inv; const float fr = (float)(rev - __builtin_floor(rev));
            const float cv = __builtin_amdgcn_cosf(fr), sv = __builtin_amdgcn_sinf(fr);
            cosT[idx] = cv; sinT[idx] = sv; cosTT[dd * 8192 + pos] = cv; sinTT[dd * 8192 + pos] = sv;
          } }
    } else if constexpr (PH == N_PHASES - 1) {
        const float* fg = a.in[15]; const float* SS = (const float*)(ws + WS_SS); float* X = a.out; const bf16_t* XB = (const bf16_t*)(ws + WS_XB);
        for (int m = gw; m < M_TOK; m += NGW) {
            const float r = pg8::rowscale(SS, m);
            const u32x2* xr = (const u32x2*)(XB + (size_t)m * DM) + lane; f32x4* orow = (f32x4*)(X + (size_t)m * DM) + lane; const f32x4* gr = (const f32x4*)fg + lane;
#pragma unroll
            for (int j = 0; j < 4; ++j) { const u32x2 w = xr[64 * j]; const f32x4 v = {bf_lo(w.x), bf_hi(w.x), bf_lo(w.y), bf_hi(w.y)}; __builtin_nontemporal_store(v * r * gr[64 * j], orow + 64 * j); }
        }
    } else {
        constexpr int l = (PH - 1) / PPL, s = (PH - 1) % PPL;
        unsigned char* wb = ws + WS_W + (size_t)l * W_STRIDE;
        if constexpr (s == 0 || s == 7) {
            pg8::Gemm g{(const bf16_t*)(ws + WS_XB), (const bf16_t*)(wb + (s == 0 ? WO_1I : WO_2I)), M_TOK, NFF, DM};
            pg8::StaticOrder S; S.init(M_TOK, NFF, G, (int)blockIdx.x); fill_rowscales(S, (const float*)(ws + WS_SS), rs, 0);
            pg8::EpiSwiGLU E{(bf16_t*)(ws + WS_H), rs, FF};
            DO_G0(pg8::gemm_phase<pg8::EpiSwiGLU, pg8::StaticOrder, true, true>(lds, g, S, E));
        } else if constexpr (s == 1 || s == 6 || s == 8) {
            pg8::Gemm g{(const bf16_t*)(ws + (s == 6 ? WS_Y : WS_H)), (const bf16_t*)(wb + (s == 1 ? WO_1O : s == 6 ? WO_MO : WO_2O)), M_TOK, DM, (s == 6) ? DM : FF};
            pg8::StaticOrder S; S.init(M_TOK, DM, G, (int)blockIdx.x);
            pg8::EpiResid E{(bf16_t*)(ws + WS_XB), (float*)(ws + WS_SS), (s == 6) ? 1.0f : 0.5f};
            DO_G1(pg8::gemm_phase<pg8::EpiResid, pg8::StaticOrder, true, true>(lds, g, S, E));
        } else if constexpr (s == 2) {
            const float* cosT = (const float*)(ws + WS_ROT);
            { pg8::Gemm g{(const bf16_t*)(ws + WS_XB), (const bf16_t*)(wb + WO_MN), M_TOK, 2304, DM};
              pg8::StaticOrder S; S.init(M_TOK, 2304, G, (int)blockIdx.x); fill_rowscales(S, (const float*)(ws + WS_SS), rs, 0);
              pg8::EpiMixN E{(bf16_t*)(ws + WS_H), rs, cosT, cosT + 262144, PW};
              if (!REP || (MI_PROBE & 1)) DO_G2(pg8::gemm_phase<pg8::EpiMixN, pg8::StaticOrder, true, true>(lds, g, S, E)); }
            { pg8::Gemm g{(const bf16_t*)(wb + WO_MT), (const bf16_t*)(ws + WS_XB), 1024, M_TOK, DM};
              pg8::StaticOrder S; S.init(1024, M_TOK, G, (int)blockIdx.x); __syncthreads(); fill_rowscales(S, (const float*)(ws + WS_SS), rs, 1);
              pg8::EpiMixT E{(bf16_t*)(ws + WS_T), rs, cosT + 2 * 262144, cosT + 3 * 262144, LDT};
              if (!REP || (MI_PROBE & 2)) DO_G3(pg8::gemm_phase<pg8::EpiMixT, pg8::StaticOrder, true, true>(lds, g, S, E)); }
        } else if constexpr (s == 3) {
            constexpr int N_R1 = 16 * NG, N_SB = SB_PART1, N_CV = M_TOK / 16, NTOT = N_R1 + N_SB + N_CV;
            const bf16_t* P = (const bf16_t*)(ws + WS_H); const bf16_t* T = (const bf16_t*)(ws + WS_T); bf16_t* Y = (bf16_t*)(ws + WS_Y);
            if (N_SB == 0 && NWAVES == 8 && 8 * G == N_CV && 2 * G == N_R1) {
                const int bid = (G % 8 == 0) ? ((int)blockIdx.x % 8) * (G / 8) + (int)blockIdx.x / 8 : (int)blockIdx.x;
                if (wave < 2) { int ln = lane; asm volatile("" : "+v"(ln) :: "memory"); DO_R1(ret1_unit(bid * 2 + wave, T, (float*)(ws + WS_G), ln, lds + wave * 16384)); }
                { int ln = lane; asm volatile("" : "+v"(ln) :: "memory"); DO_CV(conv_unit(bid * 8 + wave, P, Y, a.in[6] + l * 31 * 256, a.in[7] + l * 256, a.in[8] + l * 256, a.in[9] + l * 256, ln)); }
            } else {
            const int gwp = wave * G + (int)blockIdx.x;
            for (int it = gwp; it < NTOT; it += NGW) {
                int ln = lane; asm volatile("" : "+v"(ln) :: "memory");
                if (it < N_R1) { DO_R1(ret1_unit(it, T, (float*)(ws + WS_G), ln, lds + wave * 16384)); }
                else if (it < N_R1 + N_SB) { DO_SB(sb_unit(it - N_R1, P, T, Y, ln, lds + wave * 16384)); }
                else { DO_CV(conv_unit(it - N_R1 - N_SB, P, Y, a.in[6] + l * 31 * 256, a.in[7] + l * 256, a.in[8] + l * 256, a.in[9] + l * 256, ln)); }
            }
            }
        } else if constexpr (s == 4) {
            const float* GB = (const float*)(ws + WS_G); float* SP = (float*)(ws + WS_SP);
            for (int idx = blockIdx.x * NTHR + threadIdx.x; idx < 16 * 4096; idx += G * NTHR) {
                const int bh = idx >> 12, e = idx & 4095;
                const float cdG = EXP2(lgamma2(bh & 3) * (64.0f * GC));
                const float* gp = GB + (size_t)(bh * NG) * 4096 + e; float* sp = SP + (size_t)(bh * NG) * 4096 + e;
                float v[NG - 1];
#pragma unroll
                for (int g = 0; g < NG - 1; ++g) v[g] = gp[(size_t)g * 4096];
                float st = 0.f;
#pragma unroll
                for (int g = 0; g < NG - 1; ++g) { st = st * cdG + v[g]; sp[(size_t)(g + 1) * 4096] = st; }
            }
        } else {
            constexpr int N_R2 = 2 * 16 * NG, N_SB = 4096 - SB_PART1;
            const bf16_t* P = (const bf16_t*)(ws + WS_H); const bf16_t* T = (const bf16_t*)(ws + WS_T); bf16_t* Y = (bf16_t*)(ws + WS_Y);
            if (NWAVES == 8 && NGW >= 2048) {
                const int bid = (G % 8 == 0) ? ((int)blockIdx.x % 8) * (G / 8) + (int)blockIdx.x / 8 : (int)blockIdx.x;
                if (wave < 4) {
                    for (int it = bid * 4 + wave; it < N_R2; it += 4 * G) {
                        int ln = lane; asm volatile("" : "+v"(ln) :: "memory");
                        if (!REP || (P2_PROBE & 1)) DO_R2(ret2_unit<(REP && (P2_PROBE & 4)) ? 1 : (REP && (P2_PROBE & 8)) ? 2 : 0>(it, P, T, (const float*)(ws + WS_SP), Y, a.in[10] + l * 256, ln, lds + wave * 16384));
                    }
                    const int nmain = 12 * G < N_SB ? 12 * G : N_SB;
                    if (!REP || (P2_PROBE & 2)) for (int it = nmain + bid * 4 + wave; it < N_SB; it += 4 * G) {
                        int ln = lane; asm volatile("" : "+v"(ln) :: "memory");
                        DO_SB(sb_unit(SB_PART1 + it, P, T, Y, ln, lds + wave * 16384));
                    }
                } else {
                    const int nmain = 12 * G < N_SB ? 12 * G : N_SB;
                    if (!REP || (P2_PROBE & 2)) for (int k = 0; k < 3; ++k) {
                        const int it = bid * 12 + 4 * k + (wave - 4);
                        if (it < nmain) { int ln = lane; asm volatile("" : "+v"(ln) :: "memory"); DO_SB(sb_unit(SB_PART1 + it, P, T, Y, ln, lds + wave * 16384)); }
                    }
                    if (12 * G < N_SB && G * 4 < N_SB - 12 * G) {
                        for (int it = 12 * G + 4 * G + bid * 4 + (wave - 4); it < N_SB; it += 4 * G) { int ln = lane; asm volatile("" : "+v"(ln) :: "memory"); DO_SB(sb_unit(SB_PART1 + it, P, T, Y, ln, lds + wave * 16384)); }
                    }
                }
            } else {
                const int gwp = wave * G + (int)blockIdx.x;
                for (int it = gwp; it < N_R2; it += NGW) { int ln = lane; asm volatile("" : "+v"(ln) :: "memory"); DO_R2(ret2_unit<0>(it, P, T, (const float*)(ws + WS_SP), Y, a.in[10] + l * 256, ln, lds + wave * 16384)); }
                for (int it = gwp; it < N_SB; it += NGW) { int ln = lane; asm volatile("" : "+v"(ln) :: "memory"); DO_SB(sb_unit(SB_PART1 + it, P, T, Y, ln, lds + wave * 16384)); }
            }
        }
    }
}

__global__ void __launch_bounds__(NTHR, 2) mk_fwd(Args a) {
    extern __shared__ __attribute__((aligned(16))) unsigned char lds_raw[];
    LAS unsigned char* lds = (LAS unsigned char*)lds_raw;
    cg::grid_group grid = cg::this_grid();
    const int lane = threadIdx.x & 63, wave = __builtin_amdgcn_readfirstlane(threadIdx.x >> 6);
    const int lo = a.ph_lo, hi = a.ph_hi;
    volatile LAS unsigned* bst = (volatile LAS unsigned*)(lds + RS_OFF + RS_SLOTS * 1024);
    if (threadIdx.x < 2) bst[threadIdx.x] = 0u;
    __syncthreads();
    XcdBarrier bar; bar.bar = (unsigned*)(a.ws + WS_CTL) + 4096; bar.x = 0; bar.st = bst;
    if (hi - lo > 1) bar = xcd_barrier_post((unsigned*)(a.ws + WS_CTL) + 4096, bst);
#ifndef REP_MASK
#define REP_MASK 0
#endif
    if (hi - lo > N_PHASES) grid.sync();
#define SEAM(k) xcd_barrier(bar)
#define PHASE(k) if (lo <= (k) && (k) < hi) { if ((k) > lo) SEAM(k); run_phase<(k)>(a, lds, lane, wave); if constexpr ((REP_MASK >> (k)) & 1) { xcd_barrier(bar); run_phase<(k), 1>(a, lds, lane, wave); } }
    PHASE(0)
#ifdef EXTRA_SYNCS
    for (int i = 0; i < EXTRA_SYNCS; ++i) xcd_barrier(bar);
#endif
    PHASE(1) PHASE(2) PHASE(3) PHASE(4) PHASE(5) PHASE(6) PHASE(7) PHASE(8) PHASE(9) PHASE(10) PHASE(11) PHASE(12) PHASE(13) PHASE(14) PHASE(15) PHASE(16) PHASE(17) PHASE(18) PHASE(19)
#undef PHASE
}

#ifndef MK_SPLIT
#define MK_SPLIT 0
#endif
extern "C" void kernel_launch(void* const* d_in, const int* in_sizes, int n_in, void* d_out, int out_size, void* d_ws, size_t ws_size, hipStream_t stream) {
    static int grid = 0;
    if (grid == 0) {
        if (n_in != 16 || in_sizes[0] != M_TOK * DM || out_size != M_TOK * DM || ws_size < WS_END) { fprintf(stderr, "kernel_launch: unexpected shapes (n_in %d, in0 %d, out %d, ws %zu)\n", n_in, n_in > 0 ? in_sizes[0] : -1, out_size, ws_size); grid = -1; return; }
        int dev = 0, cus = 0, per_cu = 0;
        if (hipGetDevice(&dev) != hipSuccess || hipDeviceGetAttribute(&cus, hipDeviceAttributeMultiprocessorCount, dev) != hipSuccess) { grid = -1; return; }
        if (hipFuncSetAttribute((const void*)mk_fwd, hipFuncAttributeMaxDynamicSharedMemorySize, LDS_BYTES) != hipSuccess) { fprintf(stderr, "kernel_launch: hipFuncSetAttribute failed\n"); grid = -1; return; }
        if (hipOccupancyMaxActiveBlocksPerMultiprocessor(&per_cu, (const void*)mk_fwd, NTHR, LDS_BYTES) != hipSuccess || per_cu < 1) { fprintf(stderr, "kernel_launch: occupancy query says %d\n", per_cu); per_cu = 1; }
        (void)hipGetLastError();
        grid = cus * 1;
        if (grid * RS_SLOTS < 2816) { fprintf(stderr, "kernel_launch: %d CUs: the row-scale slots are sized for >= 235 workgroups; nothing launched\n", grid); grid = -1; return; }
    }
    if (grid < 0) return;
    (void)hipMemsetAsync((char*)d_ws + WS_CTL, 0, CTL_BYTES, stream);
    Args a{};
    for (int i = 0; i < 16; ++i) a.in[i] = (const float*)d_in[i];
    a.out = (float*)d_out; a.ws = (unsigned char*)d_ws;
#if MK_SPLIT
    for (int ph = 0; ph < N_PHASES; ++ph) {
        a.ph_lo = ph; a.ph_hi = ph + 1; void* args[] = {&a};
        hipError_t e = hipLaunchCooperativeKernel((const void*)mk_fwd, dim3(grid), dim3(NTHR), args, LDS_BYTES, stream);
        if (e != hipSuccess) { fprintf(stderr, "kernel_launch: launch %d failed: %s\n", ph, hipGetErrorString(e)); break; }
    }
#else
    a.ph_lo = 0; a.ph_hi = N_PHASES; void* args[] = {&a};
    hipError_t e = hipLaunchCooperativeKernel((const void*)mk_fwd, dim3(grid), dim3(NTHR), args, LDS_BYTES, stream);
    if (e != hipSuccess) fprintf(stderr, "kernel_launch: cooperative launch failed: %s (grid %d)\n", hipGetErrorString(e), grid);
#endif
}
```
